# Optimizing an MI355X kernel written in HIP

```python
import math
import jax, jax.numpy as jnp
from jax import lax
import numpy as np


D_MODEL = 1024
BATCH = 2
SEQ = 8192
DEPTH = 4
DEC_BATCH = 16
DEC_SEQ = 2048
PAST_LEN = 128

GRID_W = 64
HD = 64
H_A = 4
Q_LORA = 256
KV_LORA = 128
NOPE_A = 64
ROPE_A = 32
V_A = 64
H_B = 4
DIL_PATTERNS = ((128, 1), (512, 4), (2048, 16))
N_BUCKETS = 32
MAX_DISTANCE = 1024
H_C = 8
KV_C = 2
D_MIX = H_A * V_A + H_B * HD + H_C * HD
IN_SIZES = (Q_LORA, KV_LORA, ROPE_A, H_B * HD, H_B * HD, H_B * HD, H_C * HD, KV_C * HD, KV_C * HD)
N_IN = sum(IN_SIZES)
D_FF = 2816
CONV_W = 3
Q_BLOCK = 128
ROPE_THETA = 10000.0
EPS = 1e-6

kernel_name = 'hybrid_parallel_encoder'


def rms_norm(x, g):
    xf = x.astype(jnp.float32)
    y = xf * lax.rsqrt(jnp.mean(xf * xf, axis=-1, keepdims=True) + EPS)
    return (y * g.astype(jnp.float32)).astype(x.dtype)


def rope_angles(pos, n_freq):
    inv = ROPE_THETA ** (-jnp.arange(n_freq, dtype=jnp.float32) / n_freq)
    return pos.astype(jnp.float32)[:, None] * inv[None, :]


def apply_rope(x, ang):
    shape = (ang.shape[0],) + (1,) * (x.ndim - 3) + (ang.shape[1],)
    cos = jnp.cos(ang).reshape(shape).astype(x.dtype)
    sin = jnp.sin(ang).reshape(shape).astype(x.dtype)
    x1, x2 = jnp.split(x, 2, axis=-1)
    return jnp.concatenate([x1 * cos - x2 * sin, x2 * cos + x1 * sin], axis=-1)


def t5_bucket(rel):
    half = N_BUCKETS // 2
    exact = half // 2
    n = np.abs(rel)
    large = exact + (np.log(np.maximum(n, 1) / exact) / math.log(MAX_DISTANCE / exact) * (half - exact)).astype(np.int32)
    large = np.minimum(large, half - 1)
    return (np.where(rel > 0, half, 0) + np.where(n < exact, n, large)).astype(np.int32)


def block_attention(q, k, v, scale):
    b, s = q.shape[0], q.shape[1]
    nq = s // Q_BLOCK
    qb = q.reshape((b, nq, Q_BLOCK) + q.shape[2:]).swapaxes(0, 1)

    def one(qblk):
        logits = jnp.einsum('bqhgd,bkhd->bhgqk', qblk, k).astype(jnp.float32) * scale
        p = jax.nn.softmax(logits, axis=-1)
        return jnp.einsum('bhgqk,bkhd->bqhgd', p.astype(v.dtype), v)

    out = lax.map(one, qb)
    return out.swapaxes(0, 1).reshape(b, s, -1)


def dilated_window_attention(q, k, v, rel_bias, window, dilation):
    b, s, h, dh = q.shape
    w = window // (2 * dilation)
    L = s // dilation
    nb = -(-L // w)
    lp = nb * w

    def strided(a):
        return a.reshape(b, L, dilation, h, dh).transpose(0, 2, 1, 3, 4)

    qs = jnp.pad(strided(q), ((0, 0), (0, 0), (0, lp - L), (0, 0), (0, 0))).reshape(b, dilation, nb, w, h, dh)

    def windows(a):
        ap = jnp.pad(strided(a), ((0, 0), (0, 0), (w, lp - L + w), (0, 0), (0, 0))).reshape(b, dilation, nb + 2, w, h, dh)
        return jnp.concatenate([ap[:, :, :-2], ap[:, :, 1:-1], ap[:, :, 2:]], axis=3)

    kw, vw = windows(k), windows(v)
    rel = np.arange(3 * w)[None, :] - w - np.arange(w)[:, None]
    key_l = np.arange(nb)[:, None] * w + np.arange(3 * w)[None, :] - w
    mask = (np.abs(rel) <= w)[None] & ((key_l >= 0) & (key_l < L))[:, None, :]
    bias = jnp.transpose(rel_bias[t5_bucket(rel * dilation)], (2, 0, 1)).astype(jnp.float32)
    logits = jnp.einsum('brnqhd,brnkhd->brnhqk', qs, kw).astype(jnp.float32) * (dh ** -0.5) + bias
    logits = jnp.where(mask[:, None], logits, -jnp.inf)
    m = jnp.max(logits, axis=-1, keepdims=True)
    e = jnp.exp(logits - m)
    den = jnp.sum(e, axis=-1, keepdims=True)
    o = jnp.einsum('brnhqk,brnkhd->brnqhd', (e / den).astype(v.dtype), vw)
    lse = (m + jnp.log(den))[..., 0]
    o = o.reshape(b, dilation, lp, h, dh)[:, :, :L].transpose(0, 2, 1, 3, 4).reshape(b, s, h, dh)
    lse = lse.transpose(0, 1, 2, 4, 3).reshape(b, dilation, lp, h)[:, :, :L].transpose(0, 2, 1, 3).reshape(b, s, h)
    return o, lse


def mla_mixer(cq, ckv, krope, q_lora_norm, w_uq, kv_norm, w_ukv, ang):
    b, s, _ = cq.shape
    q = (rms_norm(cq, q_lora_norm) @ w_uq).reshape(b, s, H_A, NOPE_A + ROPE_A)
    kv = (rms_norm(ckv, kv_norm) @ w_ukv).reshape(b, s, H_A, NOPE_A + V_A)
    q = jnp.concatenate([q[..., :NOPE_A], apply_rope(q[..., NOPE_A:], ang)], axis=-1)
    kr = apply_rope(krope, ang)
    k = jnp.concatenate([kv[..., :NOPE_A], jnp.broadcast_to(kr[:, :, None, :], (b, s, H_A, ROPE_A))], axis=-1)
    v = kv[..., NOPE_A:]
    return block_attention(q[:, :, :, None, :], k, v, (NOPE_A + ROPE_A) ** -0.5)


def dilated_mixer(zq, zk, zv, rel_bias):
    b, s, _ = zq.shape
    q = zq.reshape(b, s, H_B, HD)
    k = zk.reshape(b, s, H_B, HD)
    v = zv.reshape(b, s, H_B, HD)
    outs, lses = [], []
    for window, dilation in DIL_PATTERNS:
        o, l = dilated_window_attention(q, k, v, rel_bias, window, dilation)
        outs.append(o)
        lses.append(l)
    wts = jax.nn.softmax(jnp.stack(lses, axis=0), axis=0)
    out = jnp.einsum('pbsh,pbshd->bshd', wts, jnp.stack(outs, axis=0).astype(jnp.float32))
    return out.astype(zq.dtype).reshape(b, s, H_B * HD)


def axial_rope(x, ang_row, ang_col):
    half = HD // 2
    return jnp.concatenate([apply_rope(x[..., :half], ang_row), apply_rope(x[..., half:], ang_col)], axis=-1)


def gqa_axial_mixer(zq, zk, zv, c_q_norm, c_k_norm, ang_row, ang_col):
    b, s, _ = zq.shape
    q = axial_rope(rms_norm(zq.reshape(b, s, H_C, HD), c_q_norm), ang_row, ang_col)
    k = axial_rope(rms_norm(zk.reshape(b, s, KV_C, HD), c_k_norm), ang_row, ang_col)
    v = zv.reshape(b, s, KV_C, HD)
    return block_attention(q.reshape(b, s, KV_C, H_C // KV_C, HD), k, v, HD ** -0.5)


def conv_gated_mlp(h, w_up, conv_w, conv_b, w_down):
    s = h.shape[1]
    u = h @ w_up
    half = CONV_W // 2
    up = jnp.pad(u, ((0, 0), (half, half), (0, 0)))
    c = conv_b
    for i in range(CONV_W):
        c = c + up[:, i:i + s] * conv_w[i]
    gate, val = jnp.split(c, 2, axis=-1)
    return (jax.nn.gelu(gate, approximate=True) * val) @ w_down


def trunk(x, rel_bias, norm_mix_pre, norm_mix_post, w_in, q_lora_norm, w_uq, kv_norm, w_ukv,
          c_q_norm, c_k_norm, w_out, norm_ffn_pre, norm_ffn_post, w_up, conv_w, conv_b, w_down):
    b, s, _ = x.shape
    rows = s // GRID_W
    ang_a = rope_angles(jnp.arange(s), ROPE_A // 2)
    row_ids = jnp.repeat(jnp.arange(rows), GRID_W)
    col_ids = jnp.tile(jnp.arange(GRID_W), rows)
    ang_row = rope_angles(row_ids, HD // 4)
    ang_col = rope_angles(col_ids, HD // 4)
    splits = [int(c) for c in np.cumsum(IN_SIZES)[:-1]]
    for l in range(DEPTH):
        h = rms_norm(x, norm_mix_pre[l])
        z = h @ w_in[l]
        a_q, a_kv, a_kr, b_q, b_k, b_v, c_q, c_k, c_v = jnp.split(z, splits, axis=-1)
        oa = mla_mixer(a_q, a_kv, a_kr, q_lora_norm[l], w_uq[l], kv_norm[l], w_ukv[l], ang_a)
        ob = dilated_mixer(b_q, b_k, b_v, rel_bias)
        oc = gqa_axial_mixer(c_q, c_k, c_v, c_q_norm[l], c_k_norm[l], ang_row, ang_col)
        mix = jnp.concatenate([oa, ob, oc], axis=-1) @ w_out[l]
        x = x + rms_norm(mix, norm_mix_post[l])
        h = rms_norm(x, norm_ffn_pre[l])
        x = x + rms_norm(conv_gated_mlp(h, w_up[l], conv_w[l], conv_b[l], w_down[l]), norm_ffn_post[l])
    return x


def setup_inputs(seed: int = 0) -> dict:
    key = jax.random.key(seed)
    ks = jax.random.split(key, 20)
    f32 = jnp.float32

    def nrm(k, shape, scale):
        return jax.random.normal(k, shape, f32) * scale

    def gain(k, shape):
        return 1.0 + 0.05 * jax.random.normal(k, shape, f32)

    return {
        'x_prompt': nrm(ks[0], (BATCH, SEQ, D_MODEL), 1.0),
        'x_sample': nrm(ks[1], (DEC_BATCH, DEC_SEQ, D_MODEL), 1.0),
        'rel_bias': nrm(ks[2], (N_BUCKETS, H_B), 0.5),
        'norm_mix_pre': gain(ks[3], (DEPTH, D_MODEL)),
        'norm_mix_post': gain(ks[4], (DEPTH, D_MODEL)),
        'w_in': nrm(ks[5], (DEPTH, D_MODEL, N_IN), D_MODEL ** -0.5),
        'q_lora_norm': gain(ks[6], (DEPTH, Q_LORA)),
        'w_uq': nrm(ks[7], (DEPTH, Q_LORA, H_A * (NOPE_A + ROPE_A)), Q_LORA ** -0.5),
        'kv_norm': gain(ks[8], (DEPTH, KV_LORA)),
        'w_ukv': nrm(ks[9], (DEPTH, KV_LORA, H_A * (NOPE_A + V_A)), KV_LORA ** -0.5),
        'c_q_norm': gain(ks[10], (DEPTH, HD)),
        'c_k_norm': gain(ks[11], (DEPTH, HD)),
        'w_out': nrm(ks[12], (DEPTH, D_MIX, D_MODEL), D_MIX ** -0.5),
        'norm_ffn_pre': gain(ks[13], (DEPTH, D_MODEL)),
        'norm_ffn_post': gain(ks[14], (DEPTH, D_MODEL)),
        'w_up': nrm(ks[15], (DEPTH, D_MODEL, 2 * D_FF), D_MODEL ** -0.5),
        'conv_w': nrm(ks[16], (DEPTH, CONV_W, 2 * D_FF), CONV_W ** -0.5),
        'conv_b': nrm(ks[17], (DEPTH, 2 * D_FF), 0.01),
        'w_down': nrm(ks[18], (DEPTH, D_FF, D_MODEL), D_FF ** -0.5),
    }


def reference(x_prompt, x_sample, rel_bias, norm_mix_pre, norm_mix_post, w_in, q_lora_norm, w_uq, kv_norm,
              w_ukv, c_q_norm, c_k_norm, w_out, norm_ffn_pre, norm_ffn_post, w_up, conv_w, conv_b, w_down):
    y_prompt = trunk(x_prompt, rel_bias, norm_mix_pre, norm_mix_post, w_in, q_lora_norm, w_uq, kv_norm, w_ukv,
                     c_q_norm, c_k_norm, w_out, norm_ffn_pre, norm_ffn_post, w_up, conv_w, conv_b, w_down)
    y_sample = trunk(x_sample, rel_bias, norm_mix_pre, norm_mix_post, w_in, q_lora_norm, w_uq, kv_norm, w_ukv,
                     c_q_norm, c_k_norm, w_out, norm_ffn_pre, norm_ffn_post, w_up, conv_w, conv_b, w_down)
    return (y_prompt, y_sample)
```

```cpp
#include <hip/hip_runtime.h>
#include <hip/hip_cooperative_groups.h>
#include <cstdio>
#include <cstdint>
namespace cg = cooperative_groups;
namespace pg8 {
#define PG8_LAS __attribute__((address_space(3)))
typedef unsigned short bf16_t;
typedef short bf16x8 __attribute__((ext_vector_type(8)));
typedef float f32x4 __attribute__((ext_vector_type(4)));
typedef unsigned u32x4 __attribute__((ext_vector_type(4)));
constexpr int BM = 256, BK = 64, HALF = 128, HTB = HALF * BK * 2  , STAGE_BYTES = 8 * HTB, NXCD = 8, WGM = 8;

__host__ __device__ __forceinline__ int lds_byte(int r, int c) { const int st = (r >> 4) * 2 + (c >> 5), rr = r & 15, cc = c & 31, ob = rr * 64 + cc * 2; return st * 1024 + (ob ^ (((ob >> 9) & 1) << 5)); }
__host__ __device__ __forceinline__ void stage_rc(int b, int& R, int& C) { const int st = b / 1024, sb = b % 1024, swz = sb ^ (((sb >> 9) & 1) << 5); R = (st >> 1) * 16 + swz / 64; C = (st & 1) * 32 + (swz % 64) / 2; }
__host__ __device__ __forceinline__ int perm32(int rho) { const int n = rho >> 4, i = rho & 15; return 8 * (i >> 2) + 4 * n + (i & 3); }

struct Unit { int pm, pn; };
struct Gemm { const bf16_t* A; const bf16_t* Bt; int M, N, K, lda; };

struct StaticOrder {
    int nM, nN, nwg, G, c;
    __host__ __device__ void init(int M, int N, int G_, int c_) { nM = M / BM; nN = N / BM; nwg = nM * nN; G = G_; c = c_; }
    __host__ __device__ bool next(int i, Unit& u) const {
        const long L = (long)i * G + c; if (L >= nwg) return false;
        int wgid = (int)L; { const int q = nwg / NXCD, r = nwg % NXCD, xcd = wgid % NXCD, off = wgid / NXCD; wgid = (xcd < r ? xcd * (q + 1) : r * (q + 1) + (xcd - r) * q) + off; }
        const int nig = WGM * nN, gid = wgid / nig, fm = gid * WGM, gsz = (nM - fm) < WGM ? (nM - fm) : WGM;
        u.pm = fm + ((wgid % nig) % gsz); u.pn = (wgid % nig) / gsz; return true;
    }
    __device__ __forceinline__ void a_ready(const Unit&) const {}
    __device__ __forceinline__ void done(const Unit&) const {}
};

__device__ __forceinline__ unsigned cvt_pk_bf16(float lo, float hi) { unsigned r; asm volatile("v_cvt_pk_bf16_f32 %0, %1, %2" : "=v"(r) : "v"(lo), "v"(hi)); return r; }
typedef float f32x2 __attribute__((ext_vector_type(2)));
__device__ __forceinline__ f32x2 gelu_pk(f32x2 v) {
    const f32x2 av = __builtin_elementwise_abs(v), d = av * 0.2316418882f + 1.0f;
    f32x2 t; t.x = __builtin_amdgcn_rcpf(d.x); t.y = __builtin_amdgcn_rcpf(d.y);
    f32x2 q = t * 0.5307027145f + (-0.7265760135f); q = q * t + 0.7107068705f; q = q * t + (-0.142248368f); q = q * t + 0.127414796f; q = q * t;
    const f32x2 s = (v * v) * (-0.72134752044f);
    f32x2 e; e.x = __builtin_amdgcn_exp2f(s.x); e.y = __builtin_amdgcn_exp2f(s.y);
    const f32x2 m = v * (q * e), r = v - m;
    f32x2 o; o.x = v.x < 0.f ? m.x : r.x; o.y = v.y < 0.f ? m.y : r.y; return o;
}

template <int ACT  > struct EpiBf16 {
    static constexpr bool PERM = true, AFTER_DRAIN = false; static_assert(ACT == 0 || ACT == 1, "EpiBf16: ACT is 0 (none) or 1 (gelu_pk)");
    bf16_t* O; int ldc; const float* bias; int split_cols; size_t split_stride; float scale0;
    __device__ __forceinline__ void operator()(const f32x4 (&acc)[2][2][4][2], const Unit& u, int wr, int wc, int fr, int fq) const {
        const int row0 = u.pm * BM + wr * 64 + fr; int colt = u.pn * BM; bf16_t* base = O;
        float sc = 1.f; if (split_cols) { const int t = colt / split_cols; base += (size_t)t * split_stride; colt -= t * split_cols; if (t == 0) sc = scale0; }
        const int col0 = colt + wc * 32 + 8 * fq, bcol0 = u.pn * BM + wc * 32 + 8 * fq;
        f32x4 bv[2][2];
#pragma unroll
        for (int bj = 0; bj < 2; ++bj)
#pragma unroll
            for (int n = 0; n < 2; ++n) bv[bj][n] = bias ? *(const f32x4*)(bias + bcol0 + bj * HALF + 4 * n) : (f32x4){0.f, 0.f, 0.f, 0.f};
#pragma unroll
        for (int ai = 0; ai < 2; ++ai)
#pragma unroll
            for (int m = 0; m < 4; ++m) { bf16_t* rowp = base + (size_t)(row0 + ai * HALF + m * 16) * ldc + col0;
#pragma unroll
                for (int bj = 0; bj < 2; ++bj) { f32x4 v0 = acc[ai][bj][m][0] + bv[bj][0], v1 = acc[ai][bj][m][1] + bv[bj][1];
                    if (ACT == 1) { f32x2 a = gelu_pk((f32x2){v0[0], v0[1]}), b = gelu_pk((f32x2){v0[2], v0[3]}), c = gelu_pk((f32x2){v1[0], v1[1]}), d = gelu_pk((f32x2){v1[2], v1[3]});
                        v0 = (f32x4){a.x, a.y, b.x, b.y}; v1 = (f32x4){c.x, c.y, d.x, d.y}; }
                    v0 = v0 * sc; v1 = v1 * sc; u32x4 w; w.x = cvt_pk_bf16(v0[0], v0[1]); w.y = cvt_pk_bf16(v0[2], v0[3]); w.z = cvt_pk_bf16(v1[0], v1[1]); w.w = cvt_pk_bf16(v1[2], v1[3]);
                    *(u32x4*)(rowp + bj * HALF) = w; } }
    }
};
template <class Epi, class Sched, bool ALIGN_EPI = false, bool SP2 = false, bool OVL = false>
__device__ __forceinline__ void gemm_phase(PG8_LAS unsigned char* lds, const Gemm g, const Sched& S, const Epi& E, int tid_l) {
    const int tid = tid_l, wid = __builtin_amdgcn_readfirstlane(tid >> 6), lane = tid & 63, wr = wid >> 2, wc = wid & 3, fr = lane & 15, fq = lane >> 4;
    const int K = g.K, nt = K / BK;
    unsigned voffA[2], voffB[2];
#pragma unroll
    for (int i = 0; i < 2; ++i) { int R, C; stage_rc(tid * 16 + i * 8192, R, C); const int Rb = Epi::PERM ? ((R & ~31) + perm32(R & 31)) : R;
        voffA[i] = (unsigned)((OVL ? (R + 62 * (R >> 6)) : R) * g.lda + C) * 2u; voffB[i] = (unsigned)(Rb * K + C) * 2u; }
    const size_t kstep = (size_t)(BK * 2);
    const size_t hstepA = (size_t)(OVL ? 64 : 128) * g.lda * 2, hstepB = (size_t)HALF * K * 2;
    const size_t tstepA = (size_t)(OVL ? 252 : 256) * g.lda * 2, tstepB = 2 * hstepB;
    const unsigned ldsw = (unsigned)wid * 1024u;
    const int aoff = lds_byte(wr * 64 + fr, fq * 8), boff = lds_byte(wc * 32 + fr, fq * 8);
#define PG8_SA(b, h) (((b) * 2 + (h)) * HTB)
#define PG8_SB(b, h) ((4 + (b) * 2 + (h)) * HTB)
#define PG8_STAGE(bufoff, gbase, voff) do { const char* gb_ = (const char*)(gbase); asm volatile("" : "+s"(gb_)); _Pragma("unroll") for (int _i = 0; _i < 2; ++_i) \
        __builtin_amdgcn_global_load_lds((const unsigned*)(gb_ + (voff)[_i]), (PG8_LAS unsigned*)(lds + (bufoff) + ldsw + _i * 8192), 16, 0, 0); } while (0)
#define PG8_LDA(dst, b, h) do { _Pragma("unroll") for (int m = 0; m < 4; ++m) _Pragma("unroll") for (int k = 0; k < 2; ++k) dst[m][k] = *(const PG8_LAS bf16x8*)(lds + PG8_SA(b, h) + aoff + m * 2048 + k * 1024); } while (0)
#define PG8_LDB(dst, b, h) do { _Pragma("unroll") for (int n = 0; n < 2; ++n) _Pragma("unroll") for (int k = 0; k < 2; ++k) dst[n][k] = *(const PG8_LAS bf16x8*)(lds + PG8_SB(b, h) + boff + n * 2048 + k * 1024); } while (0)
#define PG8_MMA(ai, bj, At, Bt) do { __builtin_amdgcn_s_setprio(1); _Pragma("unroll") for (int m = 0; m < 4; ++m) _Pragma("unroll") for (int n = 0; n < 2; ++n) _Pragma("unroll") for (int k = 0; k < 2; ++k) \
        acc[ai][bj][m][n] = __builtin_amdgcn_mfma_f32_16x16x32_bf16(Bt[n][k], At[m][k], acc[ai][bj][m][n], 0, 0, 0); __builtin_amdgcn_s_setprio(0); } while (0)
#define PG8_WAIT_V(n) asm volatile("s_waitcnt vmcnt(" #n ")" ::: "memory")
#define PG8_WAIT_L(n) asm volatile("s_waitcnt lgkmcnt(" #n ")" ::: "memory")
#define PG8_BAR __builtin_amdgcn_s_barrier()
#define PG8_SCHED __builtin_amdgcn_sched_barrier(0)
    Unit cur, nxt; int ui = 0;
    if (!S.next(0, cur)) return;
    f32x4 acc[2][2][4][2];
    float zf_ = 0.f; asm volatile("" : "+v"(zf_));
#pragma unroll
    for (int a = 0; a < 2; ++a)
#pragma unroll
        for (int b = 0; b < 2; ++b)
#pragma unroll
            for (int m = 0; m < 4; ++m)
#pragma unroll
                for (int n = 0; n < 2; ++n) acc[a][b][m][n] = (f32x4){zf_, zf_, zf_, zf_};
    bf16x8 At[4][2], B0[2][2], B1[2][2];
    const char* cA = (const char*)g.A + (size_t)cur.pm * tstepA; const char* cB = (const char*)g.Bt + (size_t)cur.pn * tstepB;
    S.a_ready(cur);
    if constexpr (SP2) {
        PG8_STAGE(PG8_SB(0, 0), cB, voffB); PG8_STAGE(PG8_SB(0, 1), cB + hstepB, voffB); PG8_STAGE(PG8_SA(0, 0), cA, voffA); PG8_STAGE(PG8_SA(0, 1), cA + hstepA, voffA);
        if (wr == 1) PG8_BAR;
        PG8_WAIT_V(2); PG8_BAR;
        PG8_STAGE(PG8_SB(1, 0), cB + kstep, voffB); PG8_STAGE(PG8_SA(1, 0), cA + kstep, voffA); PG8_STAGE(PG8_SB(1, 1), cB + hstepB + kstep, voffB);
        PG8_WAIT_V(6); PG8_BAR;
    } else {
        PG8_STAGE(PG8_SB(0, 0), cB, voffB); PG8_STAGE(PG8_SA(0, 0), cA, voffA); PG8_STAGE(PG8_SB(0, 1), cB + hstepB, voffB); PG8_STAGE(PG8_SA(0, 1), cA + hstepA, voffA);
        if (wr == 1) PG8_BAR;
        PG8_WAIT_V(4); PG8_BAR;
        PG8_STAGE(PG8_SB(1, 0), cB + kstep, voffB); PG8_STAGE(PG8_SA(1, 0), cA + kstep, voffA); PG8_STAGE(PG8_SB(1, 1), cB + hstepB + kstep, voffB);
        PG8_WAIT_V(6); PG8_BAR;
    }
    for (;;) {
        const bool has_next = S.next(ui + 1, nxt);
        const char* nA = has_next ? (const char*)g.A + (size_t)nxt.pm * tstepA : cA; const char* nB = has_next ? (const char*)g.Bt + (size_t)nxt.pn * tstepB : cB;
        for (int t = 0; t < nt; t += 2) {
            const bool last = (t == nt - 2);
            const char* a1 = cA + (size_t)(t + 1) * kstep;
            const char* a2 = last ? nA : cA + (size_t)(t + 2) * kstep; const char* b2 = last ? nB : cB + (size_t)(t + 2) * kstep;
            const char* a3 = a2 + kstep; const char* b3 = b2 + kstep;
            if (last && has_next) S.a_ready(nxt);
            if constexpr (SP2) {
            PG8_LDB(B0, 0, 0); PG8_LDB(B1, 0, 1); PG8_SCHED; PG8_LDA(At, 0, 0); PG8_STAGE(PG8_SA(1, 1), a1 + hstepA, voffA);
            PG8_WAIT_V(8); PG8_WAIT_L(0); PG8_BAR; PG8_MMA(0, 0, At, B0); PG8_MMA(0, 1, At, B1); PG8_BAR; PG8_SCHED;
            PG8_LDA(At, 0, 1); PG8_STAGE(PG8_SB(0, 0), b2, voffB); PG8_STAGE(PG8_SB(0, 1), b2 + hstepB, voffB); PG8_STAGE(PG8_SA(0, 0), a2, voffA);
            PG8_WAIT_V(8); PG8_WAIT_L(0); PG8_BAR; PG8_MMA(1, 0, At, B0); PG8_MMA(1, 1, At, B1); PG8_BAR; PG8_SCHED;
            PG8_LDB(B0, 1, 0); PG8_LDB(B1, 1, 1); PG8_SCHED; PG8_LDA(At, 1, 0); PG8_STAGE(PG8_SA(0, 1), a2 + hstepA, voffA);
            PG8_WAIT_V(8); PG8_WAIT_L(0); PG8_BAR; PG8_MMA(0, 0, At, B0); PG8_MMA(0, 1, At, B1); PG8_BAR; PG8_SCHED;
            PG8_LDA(At, 1, 1); PG8_STAGE(PG8_SB(1, 0), b3, voffB); PG8_STAGE(PG8_SB(1, 1), b3 + hstepB, voffB); PG8_STAGE(PG8_SA(1, 0), a3, voffA);
            PG8_WAIT_V(8); PG8_WAIT_L(0); PG8_BAR; PG8_MMA(1, 0, At, B0); PG8_MMA(1, 1, At, B1); PG8_BAR; PG8_SCHED;
            } else {
            PG8_LDB(B0, 0, 0); PG8_SCHED; PG8_LDA(At, 0, 0); PG8_STAGE(PG8_SA(1, 1), a1 + hstepA, voffA);
            PG8_WAIT_L(8); PG8_BAR; PG8_WAIT_L(0); PG8_MMA(0, 0, At, B0); PG8_BAR; PG8_SCHED;
            PG8_LDB(B1, 0, 1); PG8_STAGE(PG8_SB(0, 0), b2, voffB);
            PG8_BAR; PG8_WAIT_L(0); PG8_MMA(0, 1, At, B1); PG8_BAR;
            PG8_LDA(At, 0, 1); PG8_STAGE(PG8_SA(0, 0), a2, voffA);
            PG8_BAR; PG8_WAIT_L(0); PG8_MMA(1, 0, At, B0); PG8_BAR; PG8_SCHED;
            PG8_STAGE(PG8_SB(0, 1), b2 + hstepB, voffB);
            PG8_WAIT_V(6); PG8_BAR; PG8_MMA(1, 1, At, B1); PG8_BAR;
            PG8_LDB(B0, 1, 0); PG8_SCHED; PG8_LDA(At, 1, 0); PG8_STAGE(PG8_SA(0, 1), a2 + hstepA, voffA);
            PG8_WAIT_L(8); PG8_BAR; PG8_WAIT_L(0); PG8_MMA(0, 0, At, B0); PG8_BAR; PG8_SCHED;
            PG8_LDB(B1, 1, 1); PG8_STAGE(PG8_SB(1, 0), b3, voffB);
            PG8_BAR; PG8_WAIT_L(0); PG8_MMA(0, 1, At, B1); PG8_BAR;
            PG8_LDA(At, 1, 1); PG8_STAGE(PG8_SA(1, 0), a3, voffA);
            PG8_BAR; PG8_WAIT_L(0); PG8_MMA(1, 0, At, B0); PG8_BAR; PG8_SCHED;
            PG8_STAGE(PG8_SB(1, 1), b3 + hstepB, voffB);
            PG8_WAIT_V(6); PG8_BAR; PG8_MMA(1, 1, At, B1); PG8_BAR;
            }
        }
        if constexpr (ALIGN_EPI) { if (wr == 0) PG8_BAR; }
        if constexpr (!Epi::AFTER_DRAIN) { E(acc, cur, wr, wc, fr, fq); S.done(cur); }
        if (!has_next) break;
#pragma unroll
        for (int a = 0; a < 2; ++a)
#pragma unroll
            for (int b = 0; b < 2; ++b)
#pragma unroll
                for (int m = 0; m < 4; ++m)
#pragma unroll
                    for (int n = 0; n < 2; ++n) acc[a][b][m][n] = (f32x4){zf_, zf_, zf_, zf_};
        cur = nxt; cA = nA; cB = nB; ++ui;
        if constexpr (ALIGN_EPI) { if (wr == 1) PG8_BAR; }
    }
    PG8_WAIT_V(0);
    if constexpr (!ALIGN_EPI) { if (wr == 0) PG8_BAR; }
    PG8_BAR;
    if constexpr (Epi::AFTER_DRAIN) { E.fused(acc, cur, wr, wc, fr, fq, lds, wid, lane); S.done(cur); }
#undef PG8_SA
#undef PG8_SB
#undef PG8_STAGE
#undef PG8_LDA
#undef PG8_LDB
#undef PG8_MMA
#undef PG8_WAIT_V
#undef PG8_WAIT_L
#undef PG8_BAR
#undef PG8_SCHED
}
}

namespace mk {
using pg8::bf16_t; using pg8::bf16x8; using pg8::f32x4; using pg8::u32x4; using pg8::cvt_pk_bf16;
typedef float f32x16 __attribute__((ext_vector_type(16)));
typedef unsigned u32x2 __attribute__((ext_vector_type(2)));
typedef float f32x2v __attribute__((ext_vector_type(2)));
#define LAS __attribute__((address_space(3)))

constexpr int M = 49152, NP = 16384, D = 1024, DEPTH = 4, NWAVES = 8;
constexpr int ZP = 2048;
constexpr float EPS = 1e-6f, LOG2E = 1.4426950408889634f;
constexpr int ZC_AQ = 0, ZC_AKV = 256, ZC_AKR = 384, ZC_BQ = 512, ZC_BK = 768, ZC_BV = 1024, ZC_CQ = 1280, ZC_CK = 1792, ZC_CV = 1920;
constexpr int ZC_QA = 512, ZC_KA = 896, ZC_KRR = 416;
constexpr size_t OFF_WIN = 0, OFF_WUQ = OFF_WIN + 2048 * 1024, OFF_WUKV = OFF_WUQ + 512 * 256, OFF_WOUT = OFF_WUKV + 512 * 128,
                 OFF_WUP = OFF_WOUT + 1024 * 1024, OFF_WDN = OFF_WUP + 5632 * 1024, WL_STRIDE = OFF_WDN + 1024 * 2816;
constexpr size_t MiB = 1u << 20;
constexpr size_t WS_CTL = 0, WS_TAB = 1 * MiB, WS_BIAS = 2 * MiB, WS_W = 3 * MiB, WS_XB = 95 * MiB, WS_Z = 192 * MiB, WS_VA = 384 * MiB,
                 WS_OB = 408 * MiB, WS_LSE = 480 * MiB, WS_END = 483 * MiB;
static_assert(WS_W + 4 * WL_STRIDE * 2 <= WS_XB, "weights");
static_assert(WS_XB + (size_t)(M + 512) * 2048 <= WS_Z, "xb");
constexpr int LDS_BYTES = 147456;
constexpr int NPH = 1 + 9 * DEPTH;
#ifndef REP_BAR
#define REP_BAR 1
#endif
#ifndef REP_PRO
#define REP_PRO 1
#endif
#ifndef REP_ATT
#define REP_ATT 1
#endif
#ifndef REP_DIL
#define REP_DIL 1
#endif
#ifndef REP_GIN
#define REP_GIN 1
#endif
#ifndef REP_GUP
#define REP_GUP 1
#endif
#ifndef REP_GDN
#define REP_GDN 1
#endif

__device__ const float INVF[16] = {1.0f, 0.5623413324356079f, 0.3162277638912201f, 0.17782793939113617f, 0.10000000149011612f, 0.05623413249850273f,
    0.03162277489900589f, 0.017782794311642647f, 0.009999999776482582f, 0.005623413249850273f, 0.003162277629598975f, 0.0017782794311642647f,
    0.0010000000474974513f, 0.000562341301701963f, 0.0003162277571391314f, 0.00017782794020604342f};

struct Args { const float* in[19]; float* out; unsigned char* ws; int ph_lo, ph_hi; };

__device__ __forceinline__ u32x4 zero4() { unsigned z = 0u; asm volatile("" : "+v"(z)); return (u32x4){z, z, z, z}; }
__device__ __forceinline__ float bf2f(unsigned short b) { return __uint_as_float((unsigned)b << 16); }
__device__ __forceinline__ float bflo(unsigned w) { return __uint_as_float(w << 16); }
__device__ __forceinline__ float bfhi(unsigned w) { return __uint_as_float(w & 0xffff0000u); }
#define SHX(v, o) __int_as_float(__builtin_amdgcn_ds_bpermute((lane ^ (o)) << 2, __float_as_int(v)))
#define DPPF(v, ctrl) __int_as_float(__builtin_amdgcn_update_dpp(0, __float_as_int(v), (ctrl), 0xf, 0xf, false))
__device__ __forceinline__ float row16_sum(float v) { v += DPPF(v, 0x128); v += DPPF(v, 0x124); v += DPPF(v, 0x122); v += DPPF(v, 0x121); return v; }
__device__ __forceinline__ float wave_sum(float v, int lane) {
    v = row16_sum(v); v += SHX(v, 16); v += SHX(v, 32);
    return v;
}
__device__ __forceinline__ void tok_info(int T, int& t, int& S) {
    if (T < NP) { S = 8192; t = T & 8191; } else { S = 2048; t = (T - NP) & 2047; }
}

__device__ __forceinline__ void transpose_item(const float* __restrict__ W, int K, int N, const float* __restrict__ gain, bf16_t* WT, int mode, LAS float* scr, int item, int lane) {
    const int nblk = N / 32, kb = item / nblk, nb = item % nblk, k0 = 64 * kb, n0 = 32 * nb;
    float wv[32];
#pragma unroll
    for (int i = 0; i < 32; ++i) wv[i] = W[(size_t)(k0 + 2 * i + (lane >> 5)) * N + n0 + (lane & 31)];
#pragma unroll
    for (int i = 0; i < 32; ++i) { const int kk = 2 * i + (lane >> 5); const float g = gain ? gain[k0 + kk] : 1.0f; scr[kk * 33 + (lane & 31)] = wv[i] * g; }
    asm volatile("s_waitcnt lgkmcnt(0)" ::: "memory");
    int d0 = n0;
    if (mode == 1) d0 = (n0 < 416) ? n0 : n0 + 96;
    else if (mode == 2) { d0 = (n0 < 2816) ? (256 * (n0 / 128) + (n0 % 128)) : (256 * ((n0 - 2816) / 128) + 128 + ((n0 - 2816) % 128)); }
    const int c = lane & 7;
#pragma unroll
    for (int j = 0; j < 4; ++j) { const int n = (lane >> 3) + 8 * j; const LAS float* s = scr + (8 * c) * 33 + n;
        u32x4 o; o.x = cvt_pk_bf16(s[0 * 33], s[1 * 33]); o.y = cvt_pk_bf16(s[2 * 33], s[3 * 33]); o.z = cvt_pk_bf16(s[4 * 33], s[5 * 33]); o.w = cvt_pk_bf16(s[6 * 33], s[7 * 33]);
        *(u32x4*)(WT + (size_t)(d0 + n) * K + k0 + 8 * c) = o; }
    asm volatile("s_waitcnt lgkmcnt(0)" ::: "memory");
}

__device__ __forceinline__ void row_norm_store(const f32x4 (&v)[4], bf16_t* orow, int lane) {
    float s = 0.f;
#pragma unroll
    for (int j = 0; j < 4; ++j) s += (v[j].x * v[j].x + v[j].y * v[j].y) + (v[j].z * v[j].z + v[j].w * v[j].w);
    const float r = __builtin_amdgcn_rsqf(wave_sum(s, lane) * (1.0f / D) + EPS);
    u32x2* o8 = (u32x2*)orow + lane;
#pragma unroll
    for (int j = 0; j < 4; ++j) { u32x2 w; w.x = cvt_pk_bf16(v[j].x * r, v[j].y * r); w.y = cvt_pk_bf16(v[j].z * r, v[j].w * r); o8[64 * j] = w; }
}

__device__ __forceinline__ void phase_prologue(const Args& a, LAS unsigned char* lds, int G, int bid, int tid, int wid, int lane) {
    unsigned char* ws = a.ws;
    bf16_t* Wb = (bf16_t*)(ws + WS_W);
    LAS float* scr = (LAS float*)(lds + wid * 16384);
    const int gw = bid * NWAVES + wid, NGW = G * NWAVES;
    const int gt = bid * 512 + tid, NGT = G * 512;
    if (gt < 256) ((unsigned*)(ws + WS_CTL))[gt] = 0u;
    for (int i = gt; i < 3456; i += NGT) ((unsigned*)(ws + WS_CTL + 65536))[i] = 0u;
    if (gt < 19) ((const float**)(ws + WS_CTL + 1024))[gt] = a.in[gt];
    constexpr int C_IN = 16 * 61, C_UQ = 4 * 12, C_UKV = 2 * 16, C_OUT = 16 * 32, C_UP = 16 * 176, C_DN = 44 * 32, C_ALL = C_IN + C_UQ + C_UKV + C_OUT + C_UP + C_DN;
    for (int it = gw; it < DEPTH * C_ALL; it += NGW) {
        const int l = it / C_ALL; int r = it % C_ALL; bf16_t* Wl = Wb + (size_t)l * WL_STRIDE;
        if (r < C_IN) { transpose_item(a.in[5] + (size_t)l * 1024 * 1952, 1024, 1952, a.in[3] + l * 1024, Wl + OFF_WIN, 1, scr, r, lane); continue; } r -= C_IN;
        if (r < C_UQ) { transpose_item(a.in[7] + (size_t)l * 256 * 384, 256, 384, a.in[6] + l * 256, Wl + OFF_WUQ, 0, scr, r, lane); continue; } r -= C_UQ;
        if (r < C_UKV) { transpose_item(a.in[9] + (size_t)l * 128 * 512, 128, 512, a.in[8] + l * 128, Wl + OFF_WUKV, 0, scr, r, lane); continue; } r -= C_UKV;
        if (r < C_OUT) { transpose_item(a.in[12] + (size_t)l * 1024 * 1024, 1024, 1024, nullptr, Wl + OFF_WOUT, 0, scr, r, lane); continue; } r -= C_OUT;
        if (r < C_UP) { transpose_item(a.in[15] + (size_t)l * 1024 * 5632, 1024, 5632, a.in[13] + l * 1024, Wl + OFF_WUP, 2, scr, r, lane); continue; } r -= C_UP;
        transpose_item(a.in[18] + (size_t)l * 2816 * 1024, 2816, 1024, nullptr, Wl + OFF_WDN, 0, scr, r, lane);
    }
    constexpr int ZP_IN = 96 * 1024 / 8, ZP_UQ = 128 * 256 / 8;
    for (int i = gt; i < DEPTH * (ZP_IN + ZP_UQ); i += NGT) {
        const int l = i / (ZP_IN + ZP_UQ), r = i % (ZP_IN + ZP_UQ); bf16_t* Wl = Wb + (size_t)l * WL_STRIDE;
        bf16_t* p = (r < ZP_IN) ? (Wl + OFF_WIN + (size_t)416 * 1024 + (size_t)r * 8) : (Wl + OFF_WUQ + (size_t)384 * 256 + (size_t)(r - ZP_IN) * 8);
        *(u32x4*)p = zero4();
    }
    { bf16_t* xb0 = (bf16_t*)(ws + WS_XB);
      for (int i = gt; i < 2 * 256 * 1024 / 8; i += NGT) { const int half = i / (256 * 1024 / 8), r = i % (256 * 1024 / 8);
          *(u32x4*)(xb0 + (size_t)half * (size_t)(M + 256) * 1024 + (size_t)r * 8) = zero4(); } }
    { f32x2v* tab = (f32x2v*)(ws + WS_TAB);
      for (int i = gt; i < 8192 * 16; i += NGT) { const int p = i >> 4, j = i & 15; const float ang = (float)p * INVF[j];
          double rev = (double)ang * 0.15915494309189535; rev -= __builtin_rint(rev); const float f = (float)rev;
          tab[i] = (f32x2v){__builtin_amdgcn_cosf(f), __builtin_amdgcn_sinf(f)}; } }
    { float* bt = (float*)(ws + WS_BIAS); const float* rb = a.in[2];
      for (int i = gt; i < 3 * 129 * 4; i += NGT) { const int p = i / 516, jj = (i % 516) / 4 - 64, h = i & 3; const int dl = (p == 0) ? 1 : (p == 1 ? 4 : 16);
          const int rel = jj * dl, n = rel < 0 ? -rel : rel; int b;
          if (n < 8) b = n; else b = 8 + (n >= 15) + (n >= 27) + (n >= 50) + (n >= 91) + (n >= 166) + (n >= 305) + (n >= 559);
          if (rel > 0) b += 16;
          bt[i] = rb[b * 4 + h] * LOG2E; } }
    { bf16_t* XBp = (bf16_t*)(ws + WS_XB) + (size_t)256 * 1024; const int sub = lane & 15, rsel = lane >> 4;
      for (int m0 = gw * 4; m0 < M; m0 += NGW * 4) { const int m = m0 + rsel;
          const float* src = (m < NP) ? (a.in[0] + (size_t)m * D) : (a.in[1] + (size_t)(m - NP) * D);
          const f32x4* xr = (const f32x4*)src + sub; f32x4* xo = (f32x4*)(a.out + (size_t)m * D) + sub; f32x4 v[16]; float s2 = 0.f;
#pragma unroll
          for (int j = 0; j < 16; ++j) v[j] = xr[16 * j];
#pragma unroll
          for (int j = 0; j < 16; ++j) { xo[16 * j] = v[j]; s2 += (v[j].x * v[j].x + v[j].y * v[j].y) + (v[j].z * v[j].z + v[j].w * v[j].w); }
          const float r2 = __builtin_amdgcn_rsqf(row16_sum(s2) * (1.0f / D) + EPS);
          u32x2* o8 = (u32x2*)(XBp + (size_t)m * D) + sub;
#pragma unroll
          for (int j = 0; j < 16; ++j) { u32x2 w; w.x = cvt_pk_bf16(v[j].x * r2, v[j].y * r2); w.y = cvt_pk_bf16(v[j].z * r2, v[j].w * r2); o8[16 * j] = w; } } }
}

__device__ __forceinline__ void phase_resnorm(const bf16_t* Y, const float* gpost, float* X, bf16_t* XB, int G, int bid, int wid, int lane) {
    const int gw = bid * NWAVES + wid, NGW = G * NWAVES, sub = lane & 15, rsel = lane >> 4;
    const bool xa = (G == 256); const int xcd = bid & 7, lw = (bid >> 3) * NWAVES + wid;
    const int mstart = xa ? (6144 * xcd + 4 * lw) : gw * 4, mstep = xa ? 1024 : NGW * 4, mend = xa ? (6144 * xcd + 6144) : M;
    for (int m0 = mstart; m0 < mend; m0 += mstep) {
        const int m = m0 + rsel;
        const u32x2* yr = (const u32x2*)(Y + (size_t)m * D) + sub; f32x4* xr = (f32x4*)(X + (size_t)m * D) + sub;
        u32x2 yw[16]; f32x4 x[16];
#pragma unroll
        for (int j = 0; j < 16; ++j) { yw[j] = yr[16 * j]; x[j] = __builtin_nontemporal_load(&xr[16 * j]); }
        float s = 0.f;
#pragma unroll
        for (int j = 0; j < 16; ++j) { const float a0 = bflo(yw[j].x), a1 = bfhi(yw[j].x), a2 = bflo(yw[j].y), a3 = bfhi(yw[j].y); s += (a0 * a0 + a1 * a1) + (a2 * a2 + a3 * a3); }
        const float r = __builtin_amdgcn_rsqf(row16_sum(s) * (1.0f / D) + EPS);
        float s2 = 0.f;
#pragma unroll
        for (int j = 0; j < 16; ++j) { const f32x4 gp = ((const f32x4*)gpost)[sub + 16 * j]; const f32x4 y = (f32x4){bflo(yw[j].x), bfhi(yw[j].x), bflo(yw[j].y), bfhi(yw[j].y)};
            x[j] = x[j] + y * r * gp; __builtin_nontemporal_store(x[j], &xr[16 * j]); s2 += (x[j].x * x[j].x + x[j].y * x[j].y) + (x[j].z * x[j].z + x[j].w * x[j].w); }
        const float r2 = __builtin_amdgcn_rsqf(row16_sum(s2) * (1.0f / D) + EPS);
        u32x2* o8 = (u32x2*)(XB + (size_t)m * D) + sub;
#pragma unroll
        for (int j = 0; j < 16; ++j) { u32x2 w; w.x = cvt_pk_bf16(x[j].x * r2, x[j].y * r2); w.y = cvt_pk_bf16(x[j].z * r2, x[j].w * r2); o8[16 * j] = w; }
    }
}

struct TokRegs { u32x2 aq; unsigned akv; float kr; u32x4 cq, ck; f32x2v cskr; f32x2v cs[8]; int t; };
__device__ __forceinline__ void token_load(TokRegs& R, const bf16_t* Z, const f32x2v* tab, int T, int lane) {
    const bf16_t* z = Z + (size_t)T * ZP; int S; tok_info(T, R.t, S);
    R.aq = *((const u32x2*)(z + ZC_AQ) + lane); R.akv = *((const unsigned*)(z + ZC_AKV) + lane); R.kr = bf2f(z[ZC_AKR + (lane & 31)]);
    R.cq = *(const u32x4*)(z + ZC_CQ + 8 * lane); R.ck = *(const u32x4*)(z + ZC_CK + 8 * (lane & 15));
    R.cskr = tab[R.t * 16 + (lane & 15)];
    const int sub = lane & 7, jb = 8 * (sub & 1), pos = (sub < 4) ? (R.t >> 6) : (R.t & 63);
#pragma unroll
    for (int e = 0; e < 8; ++e) R.cs[e] = tab[pos * 16 + jb + e];
}
__device__ __forceinline__ void token_finish(const TokRegs& R, bf16_t* Z, const float* cqn, const float* ckn, int T, int lane) {
    bf16_t* z = Z + (size_t)T * ZP;
    { const float a0 = bflo(R.aq.x), a1 = bfhi(R.aq.x), a2 = bflo(R.aq.y), a3 = bfhi(R.aq.y);
      const float r = __builtin_amdgcn_rsqf(wave_sum((a0 * a0 + a1 * a1) + (a2 * a2 + a3 * a3), lane) * (1.0f / 256.0f) + EPS);
      u32x2 o; o.x = cvt_pk_bf16(a0 * r, a1 * r); o.y = cvt_pk_bf16(a2 * r, a3 * r); *((u32x2*)(z + ZC_AQ) + lane) = o; }
    { const float a0 = bflo(R.akv), a1 = bfhi(R.akv);
      const float r = __builtin_amdgcn_rsqf(wave_sum(a0 * a0 + a1 * a1, lane) * (1.0f / 128.0f) + EPS);
      *((unsigned*)(z + ZC_AKV) + lane) = cvt_pk_bf16(a0 * r, a1 * r); }
    { const float v = R.kr; const float pv = SHX(v, 16);
      const float o = (lane & 16) ? (v * R.cskr.x + pv * R.cskr.y) : (v * R.cskr.x - pv * R.cskr.y);
      const unsigned short ob = (unsigned short)(cvt_pk_bf16(o, 0.f) & 0xffffu);
      if (lane < 32) z[ZC_KRR + lane] = ob; }
    const int sub = lane & 7; const bool isx2 = (sub >> 1) & 1;
#pragma unroll
    for (int pass = 0; pass < 2; ++pass) {
        const bool act = (pass == 0) || (lane < 16);
        bf16_t* p = z + (pass == 0 ? ZC_CQ + 8 * lane : ZC_CK + 8 * (lane & 15));
        const float* gn = (pass == 0 ? cqn : ckn) + 8 * sub;
        const u32x4 w = (pass == 0) ? R.cq : R.ck; float v[8] = {bflo(w.x), bfhi(w.x), bflo(w.y), bfhi(w.y), bflo(w.z), bfhi(w.z), bflo(w.w), bfhi(w.w)};
        float s = 0.f;
#pragma unroll
        for (int e = 0; e < 8; ++e) s += v[e] * v[e];
        s += DPPF(s, 0xB1); s += DPPF(s, 0x4E); s += SHX(s, 4);
        const float r = __builtin_amdgcn_rsqf(s * (1.0f / 64.0f) + EPS);
        const float sc = (pass == 0) ? (0.125f * LOG2E) : 1.0f;
        float o[8];
#pragma unroll
        for (int e = 0; e < 8; ++e) { v[e] = v[e] * r * gn[e]; }
#pragma unroll
        for (int e = 0; e < 8; ++e) { const float pv = DPPF(v[e], 0x4E); o[e] = (isx2 ? (v[e] * R.cs[e].x + pv * R.cs[e].y) : (v[e] * R.cs[e].x - pv * R.cs[e].y)) * sc; }
        u32x4 ow; ow.x = cvt_pk_bf16(o[0], o[1]); ow.y = cvt_pk_bf16(o[2], o[3]); ow.z = cvt_pk_bf16(o[4], o[5]); ow.w = cvt_pk_bf16(o[6], o[7]);
        if (act) *(u32x4*)p = ow;
    }
}

#define MFMA32(a, b, c) __builtin_amdgcn_mfma_f32_32x32x16_bf16((a), (b), (c), 0, 0, 0)
__device__ __forceinline__ bf16x8 pack8(const float* p) { u32x4 w; w.x = cvt_pk_bf16(p[0], p[1]); w.y = cvt_pk_bf16(p[2], p[3]); w.z = cvt_pk_bf16(p[4], p[5]); w.w = cvt_pk_bf16(p[6], p[7]); return __builtin_bit_cast(bf16x8, w); }

__device__ __forceinline__ void dil_item(LAS unsigned char* lds, int item, const bf16_t* Z, bf16_t* OB, float* LSE, const float* biasT, int tid, int wid, int lane) {
    constexpr int KP = 72, KB = 64 * KP * 2, PAIRB = 2 * KB + 528;
    const int g = wid >> 1, hf = wid & 1, pt = tid & 127, q = lane & 31, hi = lane >> 5;
    const int rho_pi = (q & ~12) | ((q & 4) << 1) | ((q & 8) >> 1);
    const int nb = item * 4 + g, p = nb / 3072, rem = nb % 3072, h = rem / 768, blk = rem % 768;
    const int dl = (p == 0) ? 1 : (p == 1 ? 4 : 16);
    int S, sbase, k, bpr;
    if (blk < 256) { S = 8192; sbase = (blk >> 7) * 8192; k = blk & 127; bpr = 128 / dl; }
    else { const int b2 = blk - 256; S = 2048; sbase = NP + (b2 >> 5) * 2048; k = b2 & 31; bpr = 32 / dl; }
    const int r = k / bpr, n = k % bpr, L = 64 * bpr;
    LAS unsigned char* Kl = lds + g * PAIRB; LAS unsigned char* Vl = Kl + KB; LAS float* bl = (LAS float*)(Kl + 2 * KB);
    bl[pt] = biasT[(p * 129 + pt) * 4 + h]; if (pt == 0) bl[128] = biasT[(p * 129 + 128) * 4 + h];
    const int qi = 32 * hf + q; const int tq = sbase + (64 * n + qi) * dl + r;
    bf16x8 qf[4];
#pragma unroll
    for (int ks = 0; ks < 4; ++ks) qf[ks] = *(const bf16x8*)(Z + (size_t)tq * ZP + ZC_BQ + h * 64 + 16 * ks + 8 * hi);
    f32x16 oacc[2]; float zf_ = 0.f; asm volatile("" : "+v"(zf_));
#pragma unroll
    for (int i = 0; i < 16; ++i) { oacc[0][i] = zf_; oacc[1][i] = zf_; }
    float m_run = -INFINITY, l_run = 0.f;
    u32x4 kst[4], vst[2][2];
#define DIL_GLOAD(ktv) do { const int l0_ = 64 * (n + (ktv)); \
        _Pragma("unroll") for (int i_ = 0; i_ < 4; ++i_) { const int c_ = pt + 128 * i_, row_ = c_ >> 3, ch_ = c_ & 7, lk_ = l0_ + row_; kst[i_] = zero4(); \
            if (lk_ >= 0 && lk_ < L) kst[i_] = *(const u32x4*)(Z + (size_t)(sbase + lk_ * dl + r) * ZP + ZC_BK + h * 64 + 8 * ch_); } \
        _Pragma("unroll") for (int i_ = 0; i_ < 2; ++i_) { const int dch_ = (pt >> 5) + 4 * i_, kp2_ = pt & 31, lk_ = l0_ + 2 * kp2_; vst[i_][0] = zero4(); vst[i_][1] = zero4(); \
            if (lk_ >= 0 && lk_ < L) vst[i_][0] = *(const u32x4*)(Z + (size_t)(sbase + lk_ * dl + r) * ZP + ZC_BV + h * 64 + 8 * dch_); \
            if (lk_ + 1 >= 0 && lk_ + 1 < L) vst[i_][1] = *(const u32x4*)(Z + (size_t)(sbase + (lk_ + 1) * dl + r) * ZP + ZC_BV + h * 64 + 8 * dch_); } } while (0)
    DIL_GLOAD(0);
#pragma unroll 1
    for (int kti = 0; kti < 3; ++kti) {
        const int kt = (kti == 0) ? 0 : (kti == 1 ? -1 : 1); const int l0 = 64 * (n + kt);
#pragma unroll
        for (int i = 0; i < 4; ++i) { const int c = pt + 128 * i, row = c >> 3, ch = c & 7; *(LAS u32x4*)(Kl + (row * KP + 8 * ch) * 2) = kst[i]; }
#pragma unroll
        for (int i = 0; i < 2; ++i) { const int dch = (pt >> 5) + 4 * i, kp2 = pt & 31; LAS unsigned* vt = (LAS unsigned*)Vl;
#pragma unroll
            for (int e = 0; e < 8; ++e) { const unsigned a = vst[i][0][e >> 1], b = vst[i][1][e >> 1]; const unsigned w = (e & 1) ? ((a >> 16) | (b & 0xffff0000u)) : ((a & 0xffffu) | (b << 16));
                vt[(8 * dch + e) * (KP / 2) + kp2] = w; } }
        __syncthreads();
        if (kti == 0) DIL_GLOAD(-1); else if (kti == 1) DIL_GLOAD(1);
        f32x16 sacc[2];
#pragma unroll
        for (int kb = 0; kb < 2; ++kb) {
#pragma unroll
            for (int i = 0; i < 16; ++i) sacc[kb][i] = zf_;
#pragma unroll
            for (int ks = 0; ks < 4; ++ks) { const bf16x8 kf = *(const LAS bf16x8*)(Kl + ((32 * kb + rho_pi) * KP + 16 * ks + 8 * hi) * 2); sacc[kb] = MFMA32(kf, qf[ks], sacc[kb]); } }
        float mx = -INFINITY;
#pragma unroll
        for (int kb = 0; kb < 2; ++kb)
#pragma unroll
            for (int i = 0; i < 16; ++i) { const int kk = 32 * kb + 16 * (i >> 3) + 8 * hi + (i & 7); const int rel = 64 * kt + kk - qi, lk = l0 + kk;
                const bool ok = (rel >= -64) && (rel <= 64) && (lk >= 0) && (lk < L); const int bi = ok ? (rel + 64) : 64;
                const float s = ok ? (sacc[kb][i] * (0.125f * LOG2E) + bl[bi]) : -INFINITY; sacc[kb][i] = s; mx = fmaxf(mx, s); }
        mx = fmaxf(mx, SHX(mx, 32));
        const float m_new = fmaxf(m_run, mx), alpha = __builtin_amdgcn_exp2f(m_run - m_new); m_run = m_new;
        float ls = 0.f; float pr[2][16];
#pragma unroll
        for (int kb = 0; kb < 2; ++kb)
#pragma unroll
            for (int i = 0; i < 16; ++i) { const float e = __builtin_amdgcn_exp2f(sacc[kb][i] - m_new); pr[kb][i] = e; ls += e; }
        l_run = l_run * alpha + ls;
#pragma unroll
        for (int i = 0; i < 16; ++i) { oacc[0][i] *= alpha; oacc[1][i] *= alpha; }
#pragma unroll
        for (int kb = 0; kb < 2; ++kb)
#pragma unroll
            for (int s2 = 0; s2 < 2; ++s2) { const bf16x8 pf = pack8(&pr[kb][8 * s2]);
#pragma unroll
                for (int db = 0; db < 2; ++db) { const bf16x8 vf = *(const LAS bf16x8*)(Vl + ((32 * db + q) * KP + 32 * kb + 16 * s2 + 8 * hi) * 2); oacc[db] = MFMA32(vf, pf, oacc[db]); } }
        __syncthreads();
    }
#undef DIL_GLOAD
    const float lt = l_run + SHX(l_run, 32), inv = 1.0f / lt;
    bf16_t* orow = OB + ((size_t)p * M + tq) * 256 + h * 64;
#pragma unroll
    for (int db = 0; db < 2; ++db)
#pragma unroll
        for (int g4 = 0; g4 < 4; ++g4) { u32x2 w; w.x = cvt_pk_bf16(oacc[db][4 * g4] * inv, oacc[db][4 * g4 + 1] * inv); w.y = cvt_pk_bf16(oacc[db][4 * g4 + 2] * inv, oacc[db][4 * g4 + 3] * inv);
            *(u32x2*)(orow + 32 * db + 8 * g4 + 4 * hi) = w; }
    if (hi == 0) LSE[((size_t)p * M + tq) * 4 + h] = m_run + __builtin_amdgcn_logf(lt);
}

template <int DQK>
__device__ __forceinline__ void dense_item(LAS unsigned char* lds, const bf16_t* Q, int qp, const bf16_t* Kg, const bf16_t* Kg2, int kpitch, const bf16_t* Vg, int vp, bf16_t* O, int op, int nkeys,
                                           int tid, int wid, int lane) {
    constexpr int KP = DQK + 8, VP = 72, KBYTES = 64 * KP * 2, VBYTES = 64 * VP * 2, STAGE = KBYTES + VBYTES, NKS = DQK / 16, CH = DQK / 8, NKL = CH * 64 / 256;
    const int q = lane & 31, hi = lane >> 5;
    typedef __attribute__((address_space(1))) const bf16_t gbf;
    gbf* Kg_ = (gbf*)Kg; gbf* Kg2_ = (gbf*)Kg2; gbf* Vg_ = (gbf*)Vg; gbf* Q_ = (gbf*)Q;
    const int rho_pi = (q & ~12) | ((q & 4) << 1) | ((q & 8) >> 1);
    bf16x8 qf[NKS];
    { gbf* qrow = Q_ + (size_t)(wid * 32 + q) * qp + 8 * hi;
#pragma unroll
      for (int ks = 0; ks < NKS; ++ks) qf[ks] = *(const __attribute__((address_space(1))) bf16x8*)(qrow + 16 * ks); }
    f32x16 oacc[2]; float zf_ = 0.f; asm volatile("" : "+v"(zf_));
#pragma unroll
    for (int i = 0; i < 16; ++i) { oacc[0][i] = zf_; oacc[1][i] = zf_; }
    float m_run = -INFINITY, l_run = 0.f;
    u32x4 st[3];
    const int kp2 = tid & 31, dch = (tid >> 5) & 7, t2 = tid & 255;
#define DA_GLOAD(j) do { const int key0 = (j) * 64; \
        if (wid < 4) { gbf* vsrc = Vg_ + (size_t)(key0 + 2 * kp2) * vp + 8 * dch; st[0] = *(const __attribute__((address_space(1))) u32x4*)vsrc; st[1] = *(const __attribute__((address_space(1))) u32x4*)(vsrc + vp); } \
        else { _Pragma("unroll") for (int i_ = 0; i_ < NKL; ++i_) { const int c_ = t2 + 256 * i_, row_ = c_ / CH, ch_ = c_ % CH; st[i_] = *(const __attribute__((address_space(1))) u32x4*)((ch_ < 8 ? Kg_ + 8 * ch_ : Kg2_ + 8 * (ch_ - 8)) + (size_t)(key0 + row_) * kpitch); } } } while (0)
#define DA_LSTORE(s) do { LAS unsigned char* base_ = lds + (s) * STAGE; \
        if (wid < 4) { LAS unsigned* vt_ = (LAS unsigned*)(base_ + KBYTES); \
            _Pragma("unroll") for (int e_ = 0; e_ < 8; ++e_) { const unsigned a_ = st[0][e_ >> 1], b_ = st[1][e_ >> 1]; \
                const unsigned w_ = (e_ & 1) ? ((a_ >> 16) | (b_ & 0xffff0000u)) : ((a_ & 0xffffu) | (b_ << 16)); vt_[(8 * dch + e_) * (VP / 2) + kp2] = w_; } } \
        else { _Pragma("unroll") for (int i_ = 0; i_ < NKL; ++i_) { const int c_ = t2 + 256 * i_, row_ = c_ / CH, ch_ = c_ % CH; *(LAS u32x4*)(base_ + (row_ * KP + 8 * ch_) * 2) = st[i_]; } } } while (0)
    const int nt = nkeys / 64;
    f32x16 negm;
#pragma unroll
    for (int i = 0; i < 16; ++i) negm[i] = zf_;
#define DA_TILE(j, FIRST) do { \
        if ((j) + 1 < nt) DA_GLOAD((j) + 1); \
        LAS unsigned char* Kl = lds + ((j) & 1) * STAGE; LAS unsigned char* Vl = Kl + KBYTES; \
        f32x16 sacc[2]; bf16x8 kf[2][NKS]; \
        _Pragma("unroll") for (int kb = 0; kb < 2; ++kb) _Pragma("unroll") for (int ks = 0; ks < NKS; ++ks) kf[kb][ks] = *(const LAS bf16x8*)(Kl + ((32 * kb + rho_pi) * KP + 16 * ks + 8 * hi) * 2); \
        __builtin_amdgcn_sched_barrier(0); \
        _Pragma("unroll") for (int kb = 0; kb < 2; ++kb) { sacc[kb] = MFMA32(kf[kb][0], qf[0], negm); \
            _Pragma("unroll") for (int ks = 1; ks < NKS; ++ks) sacc[kb] = MFMA32(kf[kb][ks], qf[ks], sacc[kb]); } \
        bf16x8 vf[2][2][2]; \
        _Pragma("unroll") for (int kb = 0; kb < 2; ++kb) _Pragma("unroll") for (int s2 = 0; s2 < 2; ++s2) _Pragma("unroll") for (int db = 0; db < 2; ++db) \
            vf[kb][s2][db] = *(const LAS bf16x8*)(Vl + ((32 * db + q) * VP + 32 * kb + 16 * s2 + 8 * hi) * 2); \
        __builtin_amdgcn_sched_barrier(0); \
        float ls = 0.f; float pr[2][16]; \
        if (FIRST) { float mx = sacc[0][0]; \
            _Pragma("unroll") for (int i = 0; i < 16; ++i) { mx = fmaxf(mx, sacc[0][i]); mx = fmaxf(mx, sacc[1][i]); } \
            m_run = fmaxf(mx, SHX(mx, 32)); \
            _Pragma("unroll") for (int i = 0; i < 16; ++i) negm[i] = -m_run; \
            _Pragma("unroll") for (int kb = 0; kb < 2; ++kb) _Pragma("unroll") for (int i = 0; i < 16; ++i) { const float e = __builtin_amdgcn_exp2f(sacc[kb][i] - m_run); pr[kb][i] = e; ls += e; } \
        } else { \
            _Pragma("unroll") for (int kb = 0; kb < 2; ++kb) _Pragma("unroll") for (int i = 0; i < 16; ++i) { const float e = __builtin_amdgcn_exp2f(sacc[kb][i]); pr[kb][i] = e; ls += e; } \
            if (__builtin_amdgcn_ballot_w64(ls > 65536.0f) != 0ull) { \
                float d = (ls > 65536.0f) ? __builtin_amdgcn_logf(ls) : 0.f; d = fmaxf(d, SHX(d, 32)); \
                const float al = __builtin_amdgcn_exp2f(-d); m_run += d; ls *= al; l_run *= al; \
                _Pragma("unroll") for (int i = 0; i < 16; ++i) { pr[0][i] *= al; pr[1][i] *= al; oacc[0][i] *= al; oacc[1][i] *= al; negm[i] = -m_run; } \
            } \
        } \
        l_run += ls; \
        _Pragma("unroll") for (int kb = 0; kb < 2; ++kb) _Pragma("unroll") for (int s2 = 0; s2 < 2; ++s2) { const bf16x8 pf = pack8(&pr[kb][8 * s2]); \
            _Pragma("unroll") for (int db = 0; db < 2; ++db) oacc[db] = MFMA32(vf[kb][s2][db], pf, oacc[db]); } \
        if ((j) + 1 < nt) DA_LSTORE(((j) + 1) & 1); \
        __syncthreads(); } while (0)
    DA_GLOAD(0); DA_LSTORE(0);
    __syncthreads();
    DA_TILE(0, true);
    for (int j = 1; j < nt; ++j) DA_TILE(j, false);
#undef DA_TILE
#undef DA_GLOAD
#undef DA_LSTORE
    const float inv = 1.0f / (l_run + SHX(l_run, 32));
    bf16_t* orow = O + (size_t)(wid * 32 + q) * op;
#pragma unroll
    for (int db = 0; db < 2; ++db)
#pragma unroll
        for (int g4 = 0; g4 < 4; ++g4) { u32x2 w; w.x = cvt_pk_bf16(oacc[db][4 * g4] * inv, oacc[db][4 * g4 + 1] * inv); w.y = cvt_pk_bf16(oacc[db][4 * g4 + 2] * inv, oacc[db][4 * g4 + 3] * inv);
            *(u32x2*)(orow + 32 * db + 8 * g4 + 4 * hi) = w; }
}

struct EpiUq {
    static constexpr bool PERM = false, AFTER_DRAIN = false;
    bf16_t* Z; const f32x2v* tab;
    __device__ __forceinline__ void operator()(const f32x4 (&acc)[2][2][4][2], const pg8::Unit& u, int wr_, int wc_, int fr_, int fq_) const {
        int wr = wr_, wc = wc_; unsigned ones_ = ~0u; asm volatile("" : "+s"(wr), "+s"(wc), "+s"(ones_)); int ln_ = __builtin_amdgcn_mbcnt_hi(ones_, __builtin_amdgcn_mbcnt_lo(ones_, 0u)); int fr = ln_ & 15, fq = ln_ >> 4; (void)fr_; (void)fq_;
        const float qs = 0.10206207261596577f * LOG2E;
#pragma unroll
        for (int bj = 0; bj < 2; ++bj) {
            const int gidx = 8 * u.pn + 4 * bj + wc; if (gidx >= 12) continue;
            const bool rope = (gidx % 3) == 2; const int col = ZC_QA + 32 * gidx + 4 * fq;
#pragma unroll
            for (int ai = 0; ai < 2; ++ai)
#pragma unroll
                for (int m = 0; m < 4; ++m) { int frm = fr; asm volatile("" : "+v"(frm)); const int T = u.pm * 256 + ai * 128 + wr * 64 + m * 16 + frm; bf16_t* zr = Z + (size_t)T * ZP + col;
                    f32x4 x1 = acc[ai][bj][m][0], x2 = acc[ai][bj][m][1];
                    if (rope) { int t, S; tok_info(T, t, S); const f32x2v* cs = tab + t * 16 + 4 * fq; f32x4 o1, o2;
#pragma unroll
                        for (int e = 0; e < 4; ++e) { const f32x2v c = cs[e]; o1[e] = x1[e] * c.x - x2[e] * c.y; o2[e] = x2[e] * c.x + x1[e] * c.y; }
                        x1 = o1; x2 = o2; }
                    x1 = x1 * qs; x2 = x2 * qs;
                    u32x2 w; w.x = cvt_pk_bf16(x1[0], x1[1]); w.y = cvt_pk_bf16(x1[2], x1[3]); *(u32x2*)zr = w;
                    w.x = cvt_pk_bf16(x2[0], x2[1]); w.y = cvt_pk_bf16(x2[2], x2[3]); *(u32x2*)(zr + 16) = w; asm volatile("" : "+v"(fr) : "v"(w.x), "v"(w.y) : "memory"); }
        }
    }
};
struct EpiUkv {
    static constexpr bool PERM = false, AFTER_DRAIN = false;
    bf16_t* Z; bf16_t* VA;
    __device__ __forceinline__ void operator()(const f32x4 (&acc)[2][2][4][2], const pg8::Unit& u, int wr_, int wc_, int fr_, int fq_) const {
        int wr = wr_, wc = wc_; unsigned ones_ = ~0u; asm volatile("" : "+s"(wr), "+s"(wc), "+s"(ones_)); int ln_ = __builtin_amdgcn_mbcnt_hi(ones_, __builtin_amdgcn_mbcnt_lo(ones_, 0u)); int fr = ln_ & 15, fq = ln_ >> 4; (void)fr_; (void)fq_;
#pragma unroll
        for (int bj = 0; bj < 2; ++bj) { const int head = 2 * u.pn + bj;
#pragma unroll
            for (int ai = 0; ai < 2; ++ai)
#pragma unroll
                for (int m = 0; m < 4; ++m) { const int T = u.pm * 256 + ai * 128 + wr * 64 + m * 16 + fr;
                    bf16_t* dst = (wc < 2) ? (Z + (size_t)T * ZP + ZC_KA + head * 96 + 32 * wc + 4 * fq) : (VA + (size_t)T * 256 + head * 64 + 32 * (wc - 2) + 4 * fq);
#pragma unroll
                    for (int n = 0; n < 2; ++n) { const f32x4 x = acc[ai][bj][m][n]; u32x2 w; w.x = cvt_pk_bf16(x[0], x[1]); w.y = cvt_pk_bf16(x[2], x[3]); *(u32x2*)(dst + 16 * n) = w; } } }
    }
};
struct EpiUp {
    static constexpr bool PERM = false, AFTER_DRAIN = false;
    bf16_t* Gout; const float* cw; const float* cb;
    __device__ __forceinline__ void operator()(const f32x4 (&acc)[2][2][4][2], const pg8::Unit& u, int wr_, int wc_, int fr_, int fq_) const {
        int wr = wr_, wc = wc_; unsigned ones_ = ~0u; asm volatile("" : "+s"(wr), "+s"(wc), "+s"(ones_)); int ln_ = __builtin_amdgcn_mbcnt_hi(ones_, __builtin_amdgcn_mbcnt_lo(ones_, 0u)); int fr = ln_ & 15, fq = ln_ >> 4; (void)fr_; (void)fq_;
#pragma unroll
        for (int n = 0; n < 2; ++n) {
            int frm = fr; asm volatile("" : "+v"(frm));
            const int jc = 128 * u.pn + 32 * wc + 16 * n + 4 * fq;
            const int Tb = 252 * u.pm + 126 * wr - 1 + frm;
            float mu[8], md[8];
#pragma unroll
            for (int mm = 0; mm < 8; ++mm) { const int T = Tb + 16 * mm; int t, S; tok_info(T < 0 ? 0 : (T >= M ? M - 1 : T), t, S); mu[mm] = (t == 0) ? 0.f : 1.f; md[mm] = (t == S - 1) ? 0.f : 1.f; }
            float gl[8][4];
#pragma unroll
            for (int bj = 0; bj < 2; ++bj) {
                const int c = jc + 2816 * bj;
                const f32x4 w0 = *(const f32x4*)(cw + c), w1 = *(const f32x4*)(cw + 5632 + c), w2 = *(const f32x4*)(cw + 2 * 5632 + c), bb = *(const f32x4*)(cb + c);
#pragma unroll
                for (int e = 0; e < 4; ++e) {
                    float ru[8], rd[8], xv[8];
#pragma unroll
                    for (int mm = 0; mm < 8; ++mm) xv[mm] = acc[mm >> 2][bj][mm & 3][n][e];
                    asm volatile("" : "+v"(xv[0]), "+v"(xv[1]), "+v"(xv[2]), "+v"(xv[3]), "+v"(xv[4]), "+v"(xv[5]), "+v"(xv[6]), "+v"(xv[7]), "+v"(frm));
#pragma unroll
                    for (int mm = 0; mm < 8; ++mm) { ru[mm] = DPPF(xv[mm], 0x121); rd[mm] = DPPF(xv[mm], 0x12F); }
#pragma unroll
                    for (int mm = 0; mm < 8; ++mm) {
                        const float up = (frm == 0) ? ru[mm > 0 ? mm - 1 : 0] : ru[mm];
                        const float dn = (frm == 15) ? rd[mm < 7 ? mm + 1 : 7] : rd[mm];
                        const float cv = bb[e] + w1[e] * xv[mm] + (w0[e] * up) * mu[mm] + (w2[e] * dn) * md[mm];
                        if (bj == 0) { const float uu = 0.7978845608028654f * (cv + 0.044715f * cv * cv * cv);
                            gl[mm][e] = cv * __builtin_amdgcn_rcpf(1.0f + __builtin_amdgcn_exp2f(-2.8853900817779268f * uu)); }
                        else gl[mm][e] = gl[mm][e] * cv;
                    }
                    asm volatile("" : "+v"(frm) : "v"(gl[0][e]), "v"(gl[1][e]), "v"(gl[2][e]), "v"(gl[3][e]), "v"(gl[4][e]), "v"(gl[5][e]), "v"(gl[6][e]), "v"(gl[7][e]));
                }
            }
#pragma unroll
            for (int mm = 0; mm < 8; ++mm) { const int lr = 16 * mm + frm, T = Tb + 16 * mm;
                if (lr >= 1 && lr <= 126 && T < M) { u32x2 w; w.x = cvt_pk_bf16(gl[mm][0], gl[mm][1]); w.y = cvt_pk_bf16(gl[mm][2], gl[mm][3]); *(u32x2*)(Gout + (size_t)T * 2816 + jc) = w; } }
            asm volatile("" ::: "memory"); __builtin_amdgcn_sched_barrier(0);
        }
    }
};
}

using namespace mk;
#define XB_TMO      128
#define XB_XCNT(j)  (256  + 64 * (j))
#define XB_XSUB(j)  (1280 + 64 * (j))
#define XB_XGEN(j)  (2304 + 64 * (j))
#define XB_TOP      3328
#define XB_TOPGEN   3392
#define XCD_BAR_WORDS 3456
#define XB_SPIN_CAP (1u << 18)

__device__ __forceinline__ unsigned xb_ld(unsigned* p)              { return __hip_atomic_load(p, __ATOMIC_RELAXED, __HIP_MEMORY_SCOPE_AGENT); }
__device__ __forceinline__ unsigned xb_add(unsigned* p, unsigned v) { return __hip_atomic_fetch_add(p, v, __ATOMIC_RELAXED, __HIP_MEMORY_SCOPE_AGENT); }
__device__ __forceinline__ unsigned xb_xcc_id() { return (unsigned)__builtin_amdgcn_s_getreg((3 << 11) | 20) & 0xFu; }
#define XB_SPIN(cond, bar) do { unsigned _sp = 0; while (cond) { __builtin_amdgcn_s_sleep(1); \
    if ((++_sp & 255u) == 0u) { if (xb_ld(&(bar)[XB_TMO])) break; if (_sp > XB_SPIN_CAP) { atomicAdd(&(bar)[XB_TMO], 1u); break; } } } } while (0)

struct XcdBarrier {
    unsigned* bar; unsigned x;
    volatile LAS unsigned* st;
};

__device__ __forceinline__ XcdBarrier xcd_barrier_post(unsigned* bar, volatile LAS unsigned* st, bool leader) {
    XcdBarrier b; b.bar = bar; b.x = xb_xcc_id(); b.st = st;
    if (leader) (void)xb_add(&bar[XB_XCNT(b.x)], 1u);
    return b;
}
__device__ __forceinline__ void xcd_barrier_complete(unsigned* bar, unsigned x, unsigned& nloc, unsigned& nx) {
    const unsigned G = gridDim.x * gridDim.y * gridDim.z;
    unsigned sum, cnt, mine, sp = 0u;
    for (;;) {
        sum = 0u; cnt = 0u; mine = 0u;
#pragma unroll
        for (unsigned j = 0; j < 16; ++j) { const unsigned c = xb_ld(&bar[XB_XCNT(j)]); sum += c; cnt += (c > 0u) ? 1u : 0u; mine = (j == x) ? c : mine; }
        if (sum == G) break;
        __builtin_amdgcn_s_sleep(1);
        if ((++sp & 255u) == 0u) { if (xb_ld(&bar[XB_TMO])) break; if (sp > XB_SPIN_CAP) { atomicAdd(&bar[XB_TMO], 1u); break; } }
    }
    nloc = mine > 0u ? mine : 1u; nx = cnt > 0u ? cnt : 1u;
}

__device__ __forceinline__ void xcd_barrier(const XcdBarrier& b, bool leader) {
    asm volatile("s_waitcnt vmcnt(0)" ::: "memory");
    __syncthreads();
    if (leader) {
        unsigned* bar = b.bar;
        __builtin_amdgcn_s_waitcnt(0);
        unsigned nloc = b.st[0], nx = b.st[1];
        if (nloc == 0u) { xcd_barrier_complete(bar, b.x, nloc, nx); b.st[0] = nloc; b.st[1] = nx; }
        const unsigned old = xb_add(&bar[XB_XSUB(b.x)], 1u);
        const unsigned gen = old / nloc;
        if (old + 1u == (gen + 1u) * nloc) {
            __builtin_amdgcn_fence(__ATOMIC_RELEASE, "agent");
            asm volatile("s_waitcnt vmcnt(0)" ::: "memory");
            const unsigned og = xb_add(&bar[XB_TOP], 1u);
            const unsigned tg = og / nx;
            if (og + 1u == (tg + 1u) * nx) xb_add(&bar[XB_TOPGEN], 1u);
            else XB_SPIN(xb_ld(&bar[XB_TOPGEN]) == tg, bar);
            __builtin_amdgcn_fence(__ATOMIC_ACQUIRE, "agent");
            xb_add(&bar[XB_XGEN(b.x)], 1u);
            asm volatile("s_waitcnt vmcnt(0)" ::: "memory");
        } else {
            XB_SPIN(xb_ld(&bar[XB_XGEN(b.x)]) == gen, bar);
            __builtin_amdgcn_fence(__ATOMIC_ACQUIRE, "agent");
            asm volatile("s_waitcnt vmcnt(0)" ::: "memory");
        }
    }
    __syncthreads();
}

template <int PH>
__device__ __forceinline__ void run_phase(const Args& a, LAS unsigned char* lds, int wid0, int G0, int bid0) {
    LAS int* sh_item = (LAS int*)(lds + 143360);
        int G = G0, bid = bid0, wid = wid0; asm volatile("" : "+s"(G), "+s"(bid), "+s"(wid));
        const int gw = bid * NWAVES + wid, NGW = G * NWAVES;
#define FRESH_LANE() unsigned ones_ = ~0u; asm volatile("" : "+s"(ones_)); int lane = __builtin_amdgcn_mbcnt_hi(ones_, __builtin_amdgcn_mbcnt_lo(ones_, 0u)); const int tid = wid * 64 + lane; (void)tid
        unsigned char* ws = a.ws; asm volatile("" : "+s"(ws));
#define ctl ((unsigned*)(ws + WS_CTL))
#define PT ((const float* const*)(ws + WS_CTL + 1024))
#define tab ((const f32x2v*)(ws + WS_TAB))
#define biasT ((const float*)(ws + WS_BIAS))
#define Wb ((bf16_t*)(ws + WS_W))
#define XB ((bf16_t*)(ws + WS_XB) + (size_t)256 * 1024)
#define Z ((bf16_t*)(ws + WS_Z))
#define VA ((bf16_t*)(ws + WS_VA))
#define OB ((bf16_t*)(ws + WS_OB))
#define LSE ((float*)(ws + WS_LSE))
#define MIX Z
#define GB Z
#define X (a.out)
        if constexpr (PH == 0) { FRESH_LANE(); for (int rep = 0; rep < REP_PRO; ++rep) phase_prologue(a, lds, G, bid, tid, wid, lane); return; }
        constexpr int l = (PH > 0 ? PH - 1 : 0) / 9, k = (PH > 0 ? PH - 1 : 0) % 9;
#define Wl (Wb + (size_t)l * WL_STRIDE)
        if constexpr (PH == 0) { } else if constexpr (k == 0) { FRESH_LANE();
            pg8::Gemm g{XB, Wl + OFF_WIN, M, 2048, 1024, 1024}; pg8::StaticOrder S; S.init(M, 2048, G, bid);
            pg8::EpiBf16<0> E{Z, ZP, nullptr, 0, 0, 1.f};
            for (int rep = 0; rep < REP_GIN; ++rep)
            pg8::gemm_phase<pg8::EpiBf16<0>, pg8::StaticOrder, true, true>(lds, g, S, E, tid);
        } else if constexpr (k == 1) { FRESH_LANE();
            { const float* cqn = PT[10] + l * 64; const float* ckn = PT[11] + l * 64;
              for (int T = gw; T < M; T += 2 * NGW) { TokRegs R0, R1; const int T1 = (T + NGW < M) ? T + NGW : T;
                  token_load(R0, Z, tab, T, lane); token_load(R1, Z, tab, T1, lane);
                  token_finish(R0, Z, cqn, ckn, T, lane); if (T1 != T) token_finish(R1, Z, cqn, ckn, T1, lane); } }
            __syncthreads();
            for (int rep = 0; rep < REP_DIL; ++rep)
            for (int it = bid; it < 2304; it += G) dil_item(lds, it, Z, OB, LSE, biasT, tid, wid, lane);
        } else if constexpr (k == 2) { FRESH_LANE();
            { pg8::Gemm g{Z + ZC_AQ, Wl + OFF_WUQ, M, 512, 256, ZP}; pg8::StaticOrder S; S.init(M, 512, G, bid);
              EpiUq E{Z, tab}; pg8::gemm_phase<EpiUq, pg8::StaticOrder, true, true>(lds, g, S, E, tid); }
            { unsigned ones2_ = ~0u; asm volatile("" : "+s"(ones2_)); int lane2 = __builtin_amdgcn_mbcnt_hi(ones2_, __builtin_amdgcn_mbcnt_lo(ones2_, 0u));
              pg8::Gemm g{Z + ZC_AKV, Wl + OFF_WUKV, M, 512, 128, ZP}; pg8::StaticOrder S; S.init(M, 512, G, (bid + G / 2) % G);
              EpiUkv E{Z, VA}; pg8::gemm_phase<EpiUkv, pg8::StaticOrder, true, true>(lds, g, S, E, wid * 64 + lane2); }
        } else if constexpr (k == 3) { FRESH_LANE();
            for (int T = gw; T < M; T += NGW) {
                const int h = lane >> 4, d4 = (lane & 15) * 4;
                float ls[3], mx = -INFINITY;
#pragma unroll
                for (int p = 0; p < 3; ++p) { ls[p] = LSE[((size_t)p * M + T) * 4 + h]; mx = fmaxf(mx, ls[p]); }
                float den = 0.f; f32x4 o = (f32x4){0.f, 0.f, 0.f, 0.f};
#pragma unroll
                for (int p = 0; p < 3; ++p) { const float w = __builtin_amdgcn_exp2f(ls[p] - mx); den += w; const u32x2 v = *(const u32x2*)(OB + ((size_t)p * M + T) * 256 + h * 64 + d4);
                    o = o + (f32x4){bflo(v.x), bfhi(v.x), bflo(v.y), bfhi(v.y)} * w; }
                const float inv = 1.0f / den; u32x2 w; w.x = cvt_pk_bf16(o[0] * inv, o[1] * inv); w.y = cvt_pk_bf16(o[2] * inv, o[3] * inv);
                *(u32x2*)(XB + (size_t)T * 1024 + 256 + h * 64 + d4) = w;
            }
            for (int rep = 0; rep < REP_ATT; ++rep) {
            const int xme = (int)(xb_xcc_id() & 7u);
            for (int qi = 0; qi < 8; ++qi) {
                const int xq = (xme + qi) & 7;
                for (;;) {
                    if (tid == 0) *sh_item = (int)atomicAdd(ctl + 64 + (l * 2 + rep) * 8 + xq, 1u);
                    __syncthreads();
                    const int it = __builtin_amdgcn_readfirstlane(*sh_item);
                    __syncthreads();
                    if (it >= 288) break;
                    int b, h, qb, nk; size_t r0; bool isA;
                    if (it < 32) { b = xq >> 2; h = xq & 3; qb = it; r0 = (size_t)b * 8192; nk = 8192; isA = true; }
                    else if (it < 96) { const int i2 = it - 32, pc = 2 * xq + (i2 >> 5); b = pc >> 3; h = pc & 7; qb = i2 & 31; r0 = (size_t)b * 8192; nk = 8192; isA = false; }
                    else if (it < 160) { const int i2 = it - 96, pa = 8 * xq + (i2 >> 3); b = pa >> 2; h = pa & 3; qb = i2 & 7; r0 = (size_t)NP + (size_t)b * 2048; nk = 2048; isA = true; }
                    else { const int i2 = it - 160, pc = 16 * xq + (i2 >> 3); b = pc >> 3; h = pc & 7; qb = i2 & 7; r0 = (size_t)NP + (size_t)b * 2048; nk = 2048; isA = false; }
                    const size_t rq = r0 + (size_t)qb * 256;
                    if (isA) dense_item<96>(lds, Z + rq * ZP + ZC_QA + h * 96, ZP, Z + r0 * ZP + ZC_KA + h * 96, Z + r0 * ZP + ZC_KRR, ZP, VA + r0 * 256 + h * 64, 256, XB + rq * 1024 + h * 64, 1024, nk, tid, wid, lane);
                    else dense_item<64>(lds, Z + rq * ZP + ZC_CQ + h * 64, ZP, Z + r0 * ZP + ZC_CK + (h >> 2) * 64, nullptr, ZP, Z + r0 * ZP + ZC_CV + (h >> 2) * 64, ZP, XB + rq * 1024 + 512 + h * 64, 1024, nk, tid, wid, lane);
                }
            } }
        } else if constexpr (k == 4) { FRESH_LANE();
            pg8::Gemm g{XB, Wl + OFF_WOUT, M, 1024, 1024, 1024}; pg8::StaticOrder S; S.init(M, 1024, G, bid);
            pg8::EpiBf16<0> E{MIX, 1024, nullptr, 0, 0, 1.f};
            pg8::gemm_phase<pg8::EpiBf16<0>, pg8::StaticOrder, true, true>(lds, g, S, E, tid);
        } else if constexpr (k == 5) { FRESH_LANE();
            phase_resnorm(MIX, PT[4] + l * 1024, X, XB, G, bid, wid, lane);
        } else if constexpr (k == 6) { FRESH_LANE();
            pg8::Gemm g{XB - 1024, Wl + OFF_WUP, 196 * 256, 5632, 1024, 1024}; pg8::StaticOrder S; S.init(196 * 256, 5632, G, bid);
            EpiUp E{GB, PT[16] + (size_t)l * 3 * 5632, PT[17] + (size_t)l * 5632};
            for (int rep = 0; rep < REP_GUP; ++rep)
            pg8::gemm_phase<EpiUp, pg8::StaticOrder, true, true, true>(lds, g, S, E, tid);
        } else if constexpr (k == 7) { FRESH_LANE();
            pg8::Gemm g{GB, Wl + OFF_WDN, M, 1024, 2816, 2816}; pg8::StaticOrder S; S.init(M, 1024, G, bid);
            pg8::EpiBf16<0> E{XB, 1024, nullptr, 0, 0, 1.f};
            for (int rep = 0; rep < REP_GDN; ++rep)
            pg8::gemm_phase<pg8::EpiBf16<0>, pg8::StaticOrder, true, true>(lds, g, S, E, tid);
        } else { FRESH_LANE();
            phase_resnorm(XB, PT[14] + l * 1024, X, XB, G, bid, wid, lane);
        }
}
template <int PH>
__device__ __forceinline__ void run_all(const Args& a, LAS unsigned char* lds, cg::grid_group& grid, int wid0, int G0, int bid0) {
    if (a.ph_lo <= PH && PH < a.ph_hi) {
        if (PH > a.ph_lo) {
            unsigned ones_ = ~0u; asm volatile("" : "+s"(ones_)); const int lane_ = __builtin_amdgcn_mbcnt_hi(ones_, __builtin_amdgcn_mbcnt_lo(ones_, 0u));
            const bool leader = (wid0 == 0) && (lane_ == 0);
            unsigned* barw = (unsigned*)(a.ws + WS_CTL + 65536); volatile LAS unsigned* stw = (volatile LAS unsigned*)(lds + 143360 + 64);
            if constexpr (PH == 1) { grid.sync(); (void)xcd_barrier_post(barw, stw, leader); }
            else { XcdBarrier xb_; xb_.bar = barw; xb_.x = xb_xcc_id(); xb_.st = stw;
                for (int rep_ = 0; rep_ < REP_BAR; ++rep_) xcd_barrier(xb_, leader); }
        }
        run_phase<PH>(a, lds, wid0, G0, bid0);
    }
    if constexpr (PH + 1 < NPH) run_all<PH + 1>(a, lds, grid, wid0, G0, bid0);
}
__global__ void __launch_bounds__(512) mk_fwd(Args a) {
    extern __shared__ __attribute__((aligned(16))) unsigned char lds_raw[];
    LAS unsigned char* lds = (LAS unsigned char*)lds_raw;
    cg::grid_group grid = cg::this_grid();
    const int wid0 = __builtin_amdgcn_readfirstlane(threadIdx.x >> 6);
    const int G0 = gridDim.x, bid0 = blockIdx.x;
    if (threadIdx.x < 2) ((LAS unsigned*)(lds + 143360 + 64))[threadIdx.x] = 0u;
    __syncthreads();
    run_all<0>(a, lds, grid, wid0, G0, bid0);
}

extern "C" void kernel_launch(void* const* d_in, const int* in_sizes, int n_in, void* d_out, int out_size, void* d_ws, size_t ws_size, hipStream_t stream) {
    static int grid = 0;
    if (grid == 0) {
        if (n_in != 19 || out_size != M * D || ws_size < WS_END) { fprintf(stderr, "kernel_launch: unexpected shapes (n_in %d out %d ws %zu)\n", n_in, out_size, ws_size); grid = -1; return; }
        int dev = 0, cus = 0, per_cu = 0;
        hipGetDevice(&dev); hipDeviceGetAttribute(&cus, hipDeviceAttributeMultiprocessorCount, dev);
        if (hipFuncSetAttribute((const void*)mk_fwd, hipFuncAttributeMaxDynamicSharedMemorySize, LDS_BYTES) != hipSuccess) { fprintf(stderr, "kernel_launch: hipFuncSetAttribute failed\n"); grid = -1; return; }
        if (hipOccupancyMaxActiveBlocksPerMultiprocessor(&per_cu, (const void*)mk_fwd, 512, LDS_BYTES) != hipSuccess || per_cu < 1) { fprintf(stderr, "kernel_launch: occupancy query says %d\n", per_cu); per_cu = 1; }
        (void)hipGetLastError();
        grid = cus * per_cu;
    }
    if (grid < 0) return;
    Args a{};
    for (int i = 0; i < 19; ++i) a.in[i] = (const float*)d_in[i];
    a.out = (float*)d_out; a.ws = (unsigned char*)d_ws;
#ifdef MK_MULTI
    for (int ph = 0; ph < NPH; ++ph) { a.ph_lo = ph; a.ph_hi = ph + 1; hipLaunchKernelGGL(mk_fwd, dim3(grid), dim3(512), LDS_BYTES, stream, a); }
#else
    a.ph_lo = 0; a.ph_hi = NPH;
    void* args[] = {&a};
    hipError_t e = hipLaunchCooperativeKernel((const void*)mk_fwd, dim3(grid), dim3(512), args, LDS_BYTES, stream);
    if (e != hipSuccess) fprintf(stderr, "kernel_launch: cooperative launch failed: %s (grid %d)\n", hipGetErrorString(e), grid);
#endif
}
```

```cpp
#include <hip/hip_runtime.h>
#include <hip/hip_cooperative_groups.h>
#include <cstdio>
#include <cstdint>
namespace cg = cooperative_groups;
namespace pg8 {
#define PG8_LAS __attribute__((address_space(3)))
typedef unsigned short bf16_t;
typedef short bf16x8 __attribute__((ext_vector_type(8)));
typedef float f32x4 __attribute__((ext_vector_type(4)));
typedef unsigned u32x4 __attribute__((ext_vector_type(4)));
constexpr int BM = 256, BK = 64, HALF = 128, HTB = HALF * BK * 2  , STAGE_BYTES = 8 * HTB, NXCD = 8, WGM = 8;

__host__ __device__ __forceinline__ int lds_byte(int r, int c) { const int st = (r >> 4) * 2 + (c >> 5), rr = r & 15, cc = c & 31, ob = rr * 64 + cc * 2; return st * 1024 + (ob ^ (((ob >> 9) & 1) << 5)); }
__host__ __device__ __forceinline__ void stage_rc(int b, int& R, int& C) { const int st = b / 1024, sb = b % 1024, swz = sb ^ (((sb >> 9) & 1) << 5); R = (st >> 1) * 16 + swz / 64; C = (st & 1) * 32 + (swz % 64) / 2; }
__host__ __device__ __forceinline__ int perm32(int rho) { const int n = rho >> 4, i = rho & 15; return 8 * (i >> 2) + 4 * n + (i & 3); }

struct Unit { int pm, pn; };
struct Gemm { const bf16_t* A; const bf16_t* Bt; int M, N, K, lda; };

struct StaticOrder {
    int nM, nN, nwg, G, c;
    __host__ __device__ void init(int M, int N, int G_, int c_) { nM = M / BM; nN = N / BM; nwg = nM * nN; G = G_; c = c_; }
    __host__ __device__ bool next(int i, Unit& u) const {
        const long L = (long)i * G + c; if (L >= nwg) return false;
        int wgid = (int)L; { const int q = nwg / NXCD, r = nwg % NXCD, xcd = wgid % NXCD, off = wgid / NXCD; wgid = (xcd < r ? xcd * (q + 1) : r * (q + 1) + (xcd - r) * q) + off; }
        const int nig = WGM * nN, gid = wgid / nig, fm = gid * WGM, gsz = (nM - fm) < WGM ? (nM - fm) : WGM;
        u.pm = fm + ((wgid % nig) % gsz); u.pn = (wgid % nig) / gsz; return true;
    }
    __device__ __forceinline__ void a_ready(const Unit&) const {}
    __device__ __forceinline__ void done(const Unit&) const {}
};

__device__ __forceinline__ unsigned cvt_pk_bf16(float lo, float hi) { unsigned r; asm volatile("v_cvt_pk_bf16_f32 %0, %1, %2" : "=v"(r) : "v"(lo), "v"(hi)); return r; }
typedef float f32x2 __attribute__((ext_vector_type(2)));
__device__ __forceinline__ f32x2 gelu_pk(f32x2 v) {
    const f32x2 av = __builtin_elementwise_abs(v), d = av * 0.2316418882f + 1.0f;
    f32x2 t; t.x = __builtin_amdgcn_rcpf(d.x); t.y = __builtin_amdgcn_rcpf(d.y);
    f32x2 q = t * 0.5307027145f + (-0.7265760135f); q = q * t + 0.7107068705f; q = q * t + (-0.142248368f); q = q * t + 0.127414796f; q = q * t;
    const f32x2 s = (v * v) * (-0.72134752044f);
    f32x2 e; e.x = __builtin_amdgcn_exp2f(s.x); e.y = __builtin_amdgcn_exp2f(s.y);
    const f32x2 m = v * (q * e), r = v - m;
    f32x2 o; o.x = v.x < 0.f ? m.x : r.x; o.y = v.y < 0.f ? m.y : r.y; return o;
}

template <int ACT  > struct EpiBf16 {
    static constexpr bool PERM = true, AFTER_DRAIN = false; static_assert(ACT == 0 || ACT == 1, "EpiBf16: ACT is 0 (none) or 1 (gelu_pk)");
    bf16_t* O; int ldc; const float* bias; int split_cols; size_t split_stride; float scale0;
    __device__ __forceinline__ void operator()(const f32x4 (&acc)[2][2][4][2], const Unit& u, int wr, int wc, int fr, int fq) const {
        const int row0 = u.pm * BM + wr * 64 + fr; int colt = u.pn * BM; bf16_t* base = O;
        float sc = 1.f; if (split_cols) { const int t = colt / split_cols; base += (size_t)t * split_stride; colt -= t * split_cols; if (t == 0) sc = scale0; }
        const int col0 = colt + wc * 32 + 8 * fq, bcol0 = u.pn * BM + wc * 32 + 8 * fq;
        f32x4 bv[2][2];
#pragma unroll
        for (int bj = 0; bj < 2; ++bj)
#pragma unroll
            for (int n = 0; n < 2; ++n) bv[bj][n] = bias ? *(const f32x4*)(bias + bcol0 + bj * HALF + 4 * n) : (f32x4){0.f, 0.f, 0.f, 0.f};
#pragma unroll
        for (int ai = 0; ai < 2; ++ai)
#pragma unroll
            for (int m = 0; m < 4; ++m) { bf16_t* rowp = base + (size_t)(row0 + ai * HALF + m * 16) * ldc + col0;
#pragma unroll
                for (int bj = 0; bj < 2; ++bj) { f32x4 v0 = acc[ai][bj][m][0] + bv[bj][0], v1 = acc[ai][bj][m][1] + bv[bj][1];
                    if (ACT == 1) { f32x2 a = gelu_pk((f32x2){v0[0], v0[1]}), b = gelu_pk((f32x2){v0[2], v0[3]}), c = gelu_pk((f32x2){v1[0], v1[1]}), d = gelu_pk((f32x2){v1[2], v1[3]});
                        v0 = (f32x4){a.x, a.y, b.x, b.y}; v1 = (f32x4){c.x, c.y, d.x, d.y}; }
                    v0 = v0 * sc; v1 = v1 * sc; u32x4 w; w.x = cvt_pk_bf16(v0[0], v0[1]); w.y = cvt_pk_bf16(v0[2], v0[3]); w.z = cvt_pk_bf16(v1[0], v1[1]); w.w = cvt_pk_bf16(v1[2], v1[3]);
                    *(u32x4*)(rowp + bj * HALF) = w; } }
    }
};
template <class Epi, class Sched, bool ALIGN_EPI = false, bool SP2 = false, bool OVL = false>
__device__ __forceinline__ void gemm_phase(PG8_LAS unsigned char* lds, const Gemm g, const Sched& S, const Epi& E, int tid_l) {
    const int tid = tid_l, wid = __builtin_amdgcn_readfirstlane(tid >> 6), lane = tid & 63, wr = wid >> 2, wc = wid & 3, fr = lane & 15, fq = lane >> 4;
    const int K = g.K, nt = K / BK;
    unsigned voffA[2], voffB[2];
#pragma unroll
    for (int i = 0; i < 2; ++i) { int R, C; stage_rc(tid * 16 + i * 8192, R, C); const int Rb = Epi::PERM ? ((R & ~31) + perm32(R & 31)) : R;
        voffA[i] = (unsigned)((OVL ? (R + 62 * (R >> 6)) : R) * g.lda + C) * 2u; voffB[i] = (unsigned)(Rb * K + C) * 2u; }
    const size_t kstep = (size_t)(BK * 2);
    const size_t hstepA = (size_t)(OVL ? 64 : 128) * g.lda * 2, hstepB = (size_t)HALF * K * 2;
    const size_t tstepA = (size_t)(OVL ? 252 : 256) * g.lda * 2, tstepB = 2 * hstepB;
    const unsigned ldsw = (unsigned)wid * 1024u;
    const int aoff = lds_byte(wr * 64 + fr, fq * 8), boff = lds_byte(wc * 32 + fr, fq * 8);
#define PG8_SA(b, h) (((b) * 2 + (h)) * HTB)
#define PG8_SB(b, h) ((4 + (b) * 2 + (h)) * HTB)
#define PG8_STAGE(bufoff, gbase, voff) do { const char* gb_ = (const char*)(gbase); asm volatile("" : "+s"(gb_)); _Pragma("unroll") for (int _i = 0; _i < 2; ++_i) \
        __builtin_amdgcn_global_load_lds((const unsigned*)(gb_ + (voff)[_i]), (PG8_LAS unsigned*)(lds + (bufoff) + ldsw + _i * 8192), 16, 0, 0); } while (0)
#define PG8_LDA(dst, b, h) do { _Pragma("unroll") for (int m = 0; m < 4; ++m) _Pragma("unroll") for (int k = 0; k < 2; ++k) dst[m][k] = *(const PG8_LAS bf16x8*)(lds + PG8_SA(b, h) + aoff + m * 2048 + k * 1024); } while (0)
#define PG8_LDB(dst, b, h) do { _Pragma("unroll") for (int n = 0; n < 2; ++n) _Pragma("unroll") for (int k = 0; k < 2; ++k) dst[n][k] = *(const PG8_LAS bf16x8*)(lds + PG8_SB(b, h) + boff + n * 2048 + k * 1024); } while (0)
#define PG8_MMA(ai, bj, At, Bt) do { __builtin_amdgcn_s_setprio(1); _Pragma("unroll") for (int m = 0; m < 4; ++m) _Pragma("unroll") for (int n = 0; n < 2; ++n) _Pragma("unroll") for (int k = 0; k < 2; ++k) \
        acc[ai][bj][m][n] = __builtin_amdgcn_mfma_f32_16x16x32_bf16(Bt[n][k], At[m][k], acc[ai][bj][m][n], 0, 0, 0); __builtin_amdgcn_s_setprio(0); } while (0)
#define PG8_WAIT_V(n) asm volatile("s_waitcnt vmcnt(" #n ")" ::: "memory")
#define PG8_WAIT_L(n) asm volatile("s_waitcnt lgkmcnt(" #n ")" ::: "memory")
#define PG8_BAR __builtin_amdgcn_s_barrier()
#define PG8_SCHED __builtin_amdgcn_sched_barrier(0)
    Unit cur, nxt; int ui = 0;
    if (!S.next(0, cur)) return;
    f32x4 acc[2][2][4][2];
    float zf_ = 0.f; asm volatile("" : "+v"(zf_));
#pragma unroll
    for (int a = 0; a < 2; ++a)
#pragma unroll
        for (int b = 0; b < 2; ++b)
#pragma unroll
            for (int m = 0; m < 4; ++m)
#pragma unroll
                for (int n = 0; n < 2; ++n) acc[a][b][m][n] = (f32x4){zf_, zf_, zf_, zf_};
    bf16x8 At[4][2], B0[2][2], B1[2][2];
    const char* cA = (const char*)g.A + (size_t)cur.pm * tstepA; const char* cB = (const char*)g.Bt + (size_t)cur.pn * tstepB;
    S.a_ready(cur);
    if constexpr (SP2) {
        PG8_STAGE(PG8_SB(0, 0), cB, voffB); PG8_STAGE(PG8_SB(0, 1), cB + hstepB, voffB); PG8_STAGE(PG8_SA(0, 0), cA, voffA); PG8_STAGE(PG8_SA(0, 1), cA + hstepA, voffA);
        if (wr == 1) PG8_BAR;
        PG8_WAIT_V(2); PG8_BAR;
        PG8_STAGE(PG8_SB(1, 0), cB + kstep, voffB); PG8_STAGE(PG8_SA(1, 0), cA + kstep, voffA); PG8_STAGE(PG8_SB(1, 1), cB + hstepB + kstep, voffB);
        PG8_WAIT_V(6); PG8_BAR;
    } else {
        PG8_STAGE(PG8_SB(0, 0), cB, voffB); PG8_STAGE(PG8_SA(0, 0), cA, voffA); PG8_STAGE(PG8_SB(0, 1), cB + hstepB, voffB); PG8_STAGE(PG8_SA(0, 1), cA + hstepA, voffA);
        if (wr == 1) PG8_BAR;
        PG8_WAIT_V(4); PG8_BAR;
        PG8_STAGE(PG8_SB(1, 0), cB + kstep, voffB); PG8_STAGE(PG8_SA(1, 0), cA + kstep, voffA); PG8_STAGE(PG8_SB(1, 1), cB + hstepB + kstep, voffB);
        PG8_WAIT_V(6); PG8_BAR;
    }
    for (;;) {
        const bool has_next = S.next(ui + 1, nxt);
        const char* nA = has_next ? (const char*)g.A + (size_t)nxt.pm * tstepA : cA; const char* nB = has_next ? (const char*)g.Bt + (size_t)nxt.pn * tstepB : cB;
        for (int t = 0; t < nt; t += 2) {
            const bool last = (t == nt - 2);
            const char* a1 = cA + (size_t)(t + 1) * kstep;
            const char* a2 = last ? nA : cA + (size_t)(t + 2) * kstep; const char* b2 = last ? nB : cB + (size_t)(t + 2) * kstep;
            const char* a3 = a2 + kstep; const char* b3 = b2 + kstep;
            if (last && has_next) S.a_ready(nxt);
            if constexpr (SP2) {
            PG8_LDB(B0, 0, 0); PG8_LDB(B1, 0, 1); PG8_SCHED; PG8_LDA(At, 0, 0); PG8_STAGE(PG8_SA(1, 1), a1 + hstepA, voffA);
            PG8_WAIT_V(8); PG8_WAIT_L(0); PG8_BAR; PG8_MMA(0, 0, At, B0); PG8_MMA(0, 1, At, B1); PG8_BAR; PG8_SCHED;
            PG8_LDA(At, 0, 1); PG8_STAGE(PG8_SB(0, 0), b2, voffB); PG8_STAGE(PG8_SB(0, 1), b2 + hstepB, voffB); PG8_STAGE(PG8_SA(0, 0), a2, voffA);
            PG8_WAIT_V(8); PG8_WAIT_L(0); PG8_BAR; PG8_MMA(1, 0, At, B0); PG8_MMA(1, 1, At, B1); PG8_BAR; PG8_SCHED;
            PG8_LDB(B0, 1, 0); PG8_LDB(B1, 1, 1); PG8_SCHED; PG8_LDA(At, 1, 0); PG8_STAGE(PG8_SA(0, 1), a2 + hstepA, voffA);
            PG8_WAIT_V(8); PG8_WAIT_L(0); PG8_BAR; PG8_MMA(0, 0, At, B0); PG8_MMA(0, 1, At, B1); PG8_BAR; PG8_SCHED;
            PG8_LDA(At, 1, 1); PG8_STAGE(PG8_SB(1, 0), b3, voffB); PG8_STAGE(PG8_SB(1, 1), b3 + hstepB, voffB); PG8_STAGE(PG8_SA(1, 0), a3, voffA);
            PG8_WAIT_V(8); PG8_WAIT_L(0); PG8_BAR; PG8_MMA(1, 0, At, B0); PG8_MMA(1, 1, At, B1); PG8_BAR; PG8_SCHED;
            } else {
            PG8_LDB(B0, 0, 0); PG8_SCHED; PG8_LDA(At, 0, 0); PG8_STAGE(PG8_SA(1, 1), a1 + hstepA, voffA);
            PG8_WAIT_L(8); PG8_BAR; PG8_WAIT_L(0); PG8_MMA(0, 0, At, B0); PG8_BAR; PG8_SCHED;
            PG8_LDB(B1, 0, 1); PG8_STAGE(PG8_SB(0, 0), b2, voffB);
            PG8_BAR; PG8_WAIT_L(0); PG8_MMA(0, 1, At, B1); PG8_BAR;
            PG8_LDA(At, 0, 1); PG8_STAGE(PG8_SA(0, 0), a2, voffA);
            PG8_BAR; PG8_WAIT_L(0); PG8_MMA(1, 0, At, B0); PG8_BAR; PG8_SCHED;
            PG8_STAGE(PG8_SB(0, 1), b2 + hstepB, voffB);
            PG8_WAIT_V(6); PG8_BAR; PG8_MMA(1, 1, At, B1); PG8_BAR;
            PG8_LDB(B0, 1, 0); PG8_SCHED; PG8_LDA(At, 1, 0); PG8_STAGE(PG8_SA(0, 1), a2 + hstepA, voffA);
            PG8_WAIT_L(8); PG8_BAR; PG8_WAIT_L(0); PG8_MMA(0, 0, At, B0); PG8_BAR; PG8_SCHED;
            PG8_LDB(B1, 1, 1); PG8_STAGE(PG8_SB(1, 0), b3, voffB);
            PG8_BAR; PG8_WAIT_L(0); PG8_MMA(0, 1, At, B1); PG8_BAR;
            PG8_LDA(At, 1, 1); PG8_STAGE(PG8_SA(1, 0), a3, voffA);
            PG8_BAR; PG8_WAIT_L(0); PG8_MMA(1, 0, At, B0); PG8_BAR; PG8_SCHED;
            PG8_STAGE(PG8_SB(1, 1), b3 + hstepB, voffB);
            PG8_WAIT_V(6); PG8_BAR; PG8_MMA(1, 1, At, B1); PG8_BAR;
            }
        }
        if constexpr (ALIGN_EPI) { if (wr == 0) PG8_BAR; }
        if constexpr (!Epi::AFTER_DRAIN) { E(acc, cur, wr, wc, fr, fq); S.done(cur); }
        if (!has_next) break;
#pragma unroll
        for (int a = 0; a < 2; ++a)
#pragma unroll
            for (int b = 0; b < 2; ++b)
#pragma unroll
                for (int m = 0; m < 4; ++m)
#pragma unroll
                    for (int n = 0; n < 2; ++n) acc[a][b][m][n] = (f32x4){zf_, zf_, zf_, zf_};
        cur = nxt; cA = nA; cB = nB; ++ui;
        if constexpr (ALIGN_EPI) { if (wr == 1) PG8_BAR; }
    }
    PG8_WAIT_V(0);
    if constexpr (!ALIGN_EPI) { if (wr == 0) PG8_BAR; }
    PG8_BAR;
    if constexpr (Epi::AFTER_DRAIN) { E.fused(acc, cur, wr, wc, fr, fq, lds, wid, lane); S.done(cur); }
#undef PG8_SA
#undef PG8_SB
#undef PG8_STAGE
#undef PG8_LDA
#undef PG8_LDB
#undef PG8_MMA
#undef PG8_WAIT_V
#undef PG8_WAIT_L
#undef PG8_BAR
#undef PG8_SCHED
}
}

namespace mk {
using pg8::bf16_t; using pg8::bf16x8; using pg8::f32x4; using pg8::u32x4; using pg8::cvt_pk_bf16;
typedef float f32x16 __attribute__((ext_vector_type(16)));
typedef unsigned u32x2 __attribute__((ext_vector_type(2)));
typedef float f32x2v __attribute__((ext_vector_type(2)));
#define LAS __attribute__((address_space(3)))

constexpr int M = 49152, NP = 16384, D = 1024, DEPTH = 4, NWAVES = 8;
constexpr int ZP = 2048;
constexpr float EPS = 1e-6f, LOG2E = 1.4426950408889634f;
constexpr int ZC_AQ = 0, ZC_AKV = 256, ZC_AKR = 384, ZC_BQ = 512, ZC_BK = 768, ZC_BV = 1024, ZC_CQ = 1280, ZC_CK = 1792, ZC_CV = 1920;
constexpr int ZC_QA = 512, ZC_KA = 896, ZC_KRR = 416;
constexpr size_t OFF_WIN = 0, OFF_WUQ = OFF_WIN + 2048 * 1024, OFF_WUKV = OFF_WUQ + 512 * 256, OFF_WOUT = OFF_WUKV + 512 * 128,
                 OFF_WUP = OFF_WOUT + 1024 * 1024, OFF_WDN = OFF_WUP + 5632 * 1024, WL_STRIDE = OFF_WDN + 1024 * 2816;
constexpr size_t MiB = 1u << 20;
constexpr size_t WS_CTL = 0, WS_TAB = 1 * MiB, WS_BIAS = 2 * MiB, WS_W = 3 * MiB, WS_XB = 95 * MiB, WS_Z = 192 * MiB, WS_VA = 384 * MiB,
                 WS_OB = 408 * MiB, WS_LSE = 480 * MiB, WS_END = 483 * MiB;
static_assert(WS_W + 4 * WL_STRIDE * 2 <= WS_XB, "weights");
static_assert(WS_XB + (size_t)(M + 512) * 2048 <= WS_Z, "xb");
constexpr int LDS_BYTES = 147456;
constexpr int NPH = 1 + 9 * DEPTH;
#ifndef REP_BAR
#define REP_BAR 1
#endif
#ifndef REP_PRO
#define REP_PRO 1
#endif
#ifndef REP_ATT
#define REP_ATT 1
#endif
#ifndef REP_DIL
#define REP_DIL 1
#endif
#ifndef REP_GIN
#define REP_GIN 1
#endif
#ifndef REP_GUP
#define REP_GUP 1
#endif
#ifndef REP_GDN
#define REP_GDN 1
#endif

__device__ const float INVF[16] = {1.0f, 0.5623413324356079f, 0.3162277638912201f, 0.17782793939113617f, 0.10000000149011612f, 0.05623413249850273f,
    0.03162277489900589f, 0.017782794311642647f, 0.009999999776482582f, 0.005623413249850273f, 0.003162277629598975f, 0.0017782794311642647f,
    0.0010000000474974513f, 0.000562341301701963f, 0.0003162277571391314f, 0.00017782794020604342f};

struct Args { const float* in[19]; float* out; unsigned char* ws; int ph_lo, ph_hi; };

__device__ __forceinline__ u32x4 zero4() { unsigned z = 0u; asm volatile("" : "+v"(z)); return (u32x4){z, z, z, z}; }
__device__ __forceinline__ float bf2f(unsigned short b) { return __uint_as_float((unsigned)b << 16); }
__device__ __forceinline__ float bflo(unsigned w) { return __uint_as_float(w << 16); }
__device__ __forceinline__ float bfhi(unsigned w) { return __uint_as_float(w & 0xffff0000u); }
#define SHX(v, o) __int_as_float(__builtin_amdgcn_ds_bpermute((lane ^ (o)) << 2, __float_as_int(v)))
#define DPPF(v, ctrl) __int_as_float(__builtin_amdgcn_update_dpp(0, __float_as_int(v), (ctrl), 0xf, 0xf, false))
__device__ __forceinline__ float row16_sum(float v) { v += DPPF(v, 0x128); v += DPPF(v, 0x124); v += DPPF(v, 0x122); v += DPPF(v, 0x121); return v; }
__device__ __forceinline__ float wave_sum(float v, int lane) {
    v = row16_sum(v); v += SHX(v, 16); v += SHX(v, 32);
    return v;
}
__device__ __forceinline__ void tok_info(int T, int& t, int& S) {
    if (T < NP) { S = 8192; t = T & 8191; } else { S = 2048; t = (T - NP) & 2047; }
}

__device__ __forceinline__ void transpose_item(const float* __restrict__ W, int K, int N, const float* __restrict__ gain, bf16_t* WT, int mode, LAS float* scr, int item, int lane) {
    const int nblk = N / 32, kb = item / nblk, nb = item % nblk, k0 = 64 * kb, n0 = 32 * nb;
    float wv[32];
#pragma unroll
    for (int i = 0; i < 32; ++i) wv[i] = W[(size_t)(k0 + 2 * i + (lane >> 5)) * N + n0 + (lane & 31)];
#pragma unroll
    for (int i = 0; i < 32; ++i) { const int kk = 2 * i + (lane >> 5); const float g = gain ? gain[k0 + kk] : 1.0f; scr[kk * 33 + (lane & 31)] = wv[i] * g; }
    asm volatile("s_waitcnt lgkmcnt(0)" ::: "memory");
    int d0 = n0;
    if (mode == 1) d0 = (n0 < 416) ? n0 : n0 + 96;
    else if (mode == 2) { d0 = (n0 < 2816) ? (256 * (n0 / 128) + (n0 % 128)) : (256 * ((n0 - 2816) / 128) + 128 + ((n0 - 2816) % 128)); }
    const int c = lane & 7;
#pragma unroll
    for (int j = 0; j < 4; ++j) { const int n = (lane >> 3) + 8 * j; const LAS float* s = scr + (8 * c) * 33 + n;
        u32x4 o; o.x = cvt_pk_bf16(s[0 * 33], s[1 * 33]); o.y = cvt_pk_bf16(s[2 * 33], s[3 * 33]); o.z = cvt_pk_bf16(s[4 * 33], s[5 * 33]); o.w = cvt_pk_bf16(s[6 * 33], s[7 * 33]);
        *(u32x4*)(WT + (size_t)(d0 + n) * K + k0 + 8 * c) = o; }
    asm volatile("s_waitcnt lgkmcnt(0)" ::: "memory");
}

__device__ __forceinline__ void row_norm_store(const f32x4 (&v)[4], bf16_t* orow, int lane) {
    float s = 0.f;
#pragma unroll
    for (int j = 0; j < 4; ++j) s += (v[j].x * v[j].x + v[j].y * v[j].y) + (v[j].z * v[j].z + v[j].w * v[j].w);
    const float r = __builtin_amdgcn_rsqf(wave_sum(s, lane) * (1.0f / D) + EPS);
    u32x2* o8 = (u32x2*)orow + lane;
#pragma unroll
    for (int j = 0; j < 4; ++j) { u32x2 w; w.x = cvt_pk_bf16(v[j].x * r, v[j].y * r); w.y = cvt_pk_bf16(v[j].z * r, v[j].w * r); o8[64 * j] = w; }
}

__device__ __forceinline__ void phase_prologue(const Args& a, LAS unsigned char* lds, int G, int bid, int tid, int wid, int lane) {
    unsigned char* ws = a.ws;
    bf16_t* Wb = (bf16_t*)(ws + WS_W);
    LAS float* scr = (LAS float*)(lds + wid * 16384);
    const int gw = bid * NWAVES + wid, NGW = G * NWAVES;
    const int gt = bid * 512 + tid, NGT = G * 512;
    if (gt < 256) ((unsigned*)(ws + WS_CTL))[gt] = 0u;
    for (int i = gt; i < 3456; i += NGT) ((unsigned*)(ws + WS_CTL + 65536))[i] = 0u;
    if (gt < 19) ((const float**)(ws + WS_CTL + 1024))[gt] = a.in[gt];
    constexpr int C_IN = 16 * 61, C_UQ = 4 * 12, C_UKV = 2 * 16, C_OUT = 16 * 32, C_UP = 16 * 176, C_DN = 44 * 32, C_ALL = C_IN + C_UQ + C_UKV + C_OUT + C_UP + C_DN;
    for (int it = gw; it < DEPTH * C_ALL; it += NGW) {
        const int l = it / C_ALL; int r = it % C_ALL; bf16_t* Wl = Wb + (size_t)l * WL_STRIDE;
        if (r < C_IN) { transpose_item(a.in[5] + (size_t)l * 1024 * 1952, 1024, 1952, a.in[3] + l * 1024, Wl + OFF_WIN, 1, scr, r, lane); continue; } r -= C_IN;
        if (r < C_UQ) { transpose_item(a.in[7] + (size_t)l * 256 * 384, 256, 384, a.in[6] + l * 256, Wl + OFF_WUQ, 0, scr, r, lane); continue; } r -= C_UQ;
        if (r < C_UKV) { transpose_item(a.in[9] + (size_t)l * 128 * 512, 128, 512, a.in[8] + l * 128, Wl + OFF_WUKV, 0, scr, r, lane); continue; } r -= C_UKV;
        if (r < C_OUT) { transpose_item(a.in[12] + (size_t)l * 1024 * 1024, 1024, 1024, nullptr, Wl + OFF_WOUT, 0, scr, r, lane); continue; } r -= C_OUT;
        if (r < C_UP) { transpose_item(a.in[15] + (size_t)l * 1024 * 5632, 1024, 5632, a.in[13] + l * 1024, Wl + OFF_WUP, 2, scr, r, lane); continue; } r -= C_UP;
        transpose_item(a.in[18] + (size_t)l * 2816 * 1024, 2816, 1024, nullptr, Wl + OFF_WDN, 0, scr, r, lane);
    }
    constexpr int ZP_IN = 96 * 1024 / 8, ZP_UQ = 128 * 256 / 8;
    for (int i = gt; i < DEPTH * (ZP_IN + ZP_UQ); i += NGT) {
        const int l = i / (ZP_IN + ZP_UQ), r = i % (ZP_IN + ZP_UQ); bf16_t* Wl = Wb + (size_t)l * WL_STRIDE;
        bf16_t* p = (r < ZP_IN) ? (Wl + OFF_WIN + (size_t)416 * 1024 + (size_t)r * 8) : (Wl + OFF_WUQ + (size_t)384 * 256 + (size_t)(r - ZP_IN) * 8);
        *(u32x4*)p = zero4();
    }
    { bf16_t* xb0 = (bf16_t*)(ws + WS_XB);
      for (int i = gt; i < 2 * 256 * 1024 / 8; i += NGT) { const int half = i / (256 * 1024 / 8), r = i % (256 * 1024 / 8);
          *(u32x4*)(xb0 + (size_t)half * (size_t)(M + 256) * 1024 + (size_t)r * 8) = zero4(); } }
    { f32x2v* tab = (f32x2v*)(ws + WS_TAB);
      for (int i = gt; i < 8192 * 16; i += NGT) { const int p = i >> 4, j = i & 15; const float ang = (float)p * INVF[j];
          double rev = (double)ang * 0.15915494309189535; rev -= __builtin_rint(rev); const float f = (float)rev;
          tab[i] = (f32x2v){__builtin_amdgcn_cosf(f), __builtin_amdgcn_sinf(f)}; } }
    { float* bt = (float*)(ws + WS_BIAS); const float* rb = a.in[2];
      for (int i = gt; i < 3 * 129 * 4; i += NGT) { const int p = i / 516, jj = (i % 516) / 4 - 64, h = i & 3; const int dl = (p == 0) ? 1 : (p == 1 ? 4 : 16);
          const int rel = jj * dl, n = rel < 0 ? -rel : rel; int b;
          if (n < 8) b = n; else b = 8 + (n >= 15) + (n >= 27) + (n >= 50) + (n >= 91) + (n >= 166) + (n >= 305) + (n >= 559);
          if (rel > 0) b += 16;
          bt[i] = rb[b * 4 + h] * LOG2E; } }
    { bf16_t* XBp = (bf16_t*)(ws + WS_XB) + (size_t)256 * 1024; const int sub = lane & 15, rsel = lane >> 4;
      for (int m0 = gw * 4; m0 < M; m0 += NGW * 4) { const int m = m0 + rsel;
          const float* src = (m < NP) ? (a.in[0] + (size_t)m * D) : (a.in[1] + (size_t)(m - NP) * D);
          const f32x4* xr = (const f32x4*)src + sub; f32x4* xo = (f32x4*)(a.out + (size_t)m * D) + sub; f32x4 v[16]; float s2 = 0.f;
#pragma unroll
          for (int j = 0; j < 16; ++j) v[j] = xr[16 * j];
#pragma unroll
          for (int j = 0; j < 16; ++j) { xo[16 * j] = v[j]; s2 += (v[j].x * v[j].x + v[j].y * v[j].y) + (v[j].z * v[j].z + v[j].w * v[j].w); }
          const float r2 = __builtin_amdgcn_rsqf(row16_sum(s2) * (1.0f / D) + EPS);
          u32x2* o8 = (u32x2*)(XBp + (size_t)m * D) + sub;
#pragma unroll
          for (int j = 0; j < 16; ++j) { u32x2 w; w.x = cvt_pk_bf16(v[j].x * r2, v[j].y * r2); w.y = cvt_pk_bf16(v[j].z * r2, v[j].w * r2); o8[16 * j] = w; } } }
}

__device__ __forceinline__ void phase_resnorm(const bf16_t* Y, const float* gpost, float* X, bf16_t* XB, int G, int bid, int wid, int lane) {
    const int gw = bid * NWAVES + wid, NGW = G * NWAVES, sub = lane & 15, rsel = lane >> 4;
    for (int m0 = gw * 4; m0 < M; m0 += NGW * 4) {
        const int m = m0 + rsel;
        const u32x2* yr = (const u32x2*)(Y + (size_t)m * D) + sub; f32x4* xr = (f32x4*)(X + (size_t)m * D) + sub;
        u32x2 yw[16]; f32x4 x[16];
#pragma unroll
        for (int j = 0; j < 16; ++j) { yw[j] = yr[16 * j]; x[j] = __builtin_nontemporal_load(&xr[16 * j]); }
        float s = 0.f;
#pragma unroll
        for (int j = 0; j < 16; ++j) { const float a0 = bflo(yw[j].x), a1 = bfhi(yw[j].x), a2 = bflo(yw[j].y), a3 = bfhi(yw[j].y); s += (a0 * a0 + a1 * a1) + (a2 * a2 + a3 * a3); }
        const float r = __builtin_amdgcn_rsqf(row16_sum(s) * (1.0f / D) + EPS);
        float s2 = 0.f;
#pragma unroll
        for (int j = 0; j < 16; ++j) { const f32x4 gp = ((const f32x4*)gpost)[sub + 16 * j]; const f32x4 y = (f32x4){bflo(yw[j].x), bfhi(yw[j].x), bflo(yw[j].y), bfhi(yw[j].y)};
            x[j] = x[j] + y * r * gp; __builtin_nontemporal_store(x[j], &xr[16 * j]); s2 += (x[j].x * x[j].x + x[j].y * x[j].y) + (x[j].z * x[j].z + x[j].w * x[j].w); }
        const float r2 = __builtin_amdgcn_rsqf(row16_sum(s2) * (1.0f / D) + EPS);
        u32x2* o8 = (u32x2*)(XB + (size_t)m * D) + sub;
#pragma unroll
        for (int j = 0; j < 16; ++j) { u32x2 w; w.x = cvt_pk_bf16(x[j].x * r2, x[j].y * r2); w.y = cvt_pk_bf16(x[j].z * r2, x[j].w * r2); o8[16 * j] = w; }
    }
}

struct TokRegs { u32x2 aq; unsigned akv; float kr; u32x4 cq, ck; f32x2v cskr; f32x2v cs[8]; int t; };
__device__ __forceinline__ void token_load(TokRegs& R, const bf16_t* Z, const f32x2v* tab, int T, int lane) {
    const bf16_t* z = Z + (size_t)T * ZP; int S; tok_info(T, R.t, S);
    R.aq = *((const u32x2*)(z + ZC_AQ) + lane); R.akv = *((const unsigned*)(z + ZC_AKV) + lane); R.kr = bf2f(z[ZC_AKR + (lane & 31)]);
    R.cq = *(const u32x4*)(z + ZC_CQ + 8 * lane); R.ck = *(const u32x4*)(z + ZC_CK + 8 * (lane & 15));
    R.cskr = tab[R.t * 16 + (lane & 15)];
    const int sub = lane & 7, jb = 8 * (sub & 1), pos = (sub < 4) ? (R.t >> 6) : (R.t & 63);
#pragma unroll
    for (int e = 0; e < 8; ++e) R.cs[e] = tab[pos * 16 + jb + e];
}
__device__ __forceinline__ void token_finish(const TokRegs& R, bf16_t* Z, const float* cqn, const float* ckn, int T, int lane) {
    bf16_t* z = Z + (size_t)T * ZP;
    { const float a0 = bflo(R.aq.x), a1 = bfhi(R.aq.x), a2 = bflo(R.aq.y), a3 = bfhi(R.aq.y);
      const float r = __builtin_amdgcn_rsqf(wave_sum((a0 * a0 + a1 * a1) + (a2 * a2 + a3 * a3), lane) * (1.0f / 256.0f) + EPS);
      u32x2 o; o.x = cvt_pk_bf16(a0 * r, a1 * r); o.y = cvt_pk_bf16(a2 * r, a3 * r); *((u32x2*)(z + ZC_AQ) + lane) = o; }
    { const float a0 = bflo(R.akv), a1 = bfhi(R.akv);
      const float r = __builtin_amdgcn_rsqf(wave_sum(a0 * a0 + a1 * a1, lane) * (1.0f / 128.0f) + EPS);
      *((unsigned*)(z + ZC_AKV) + lane) = cvt_pk_bf16(a0 * r, a1 * r); }
    { const float v = R.kr; const float pv = SHX(v, 16);
      const float o = (lane & 16) ? (v * R.cskr.x + pv * R.cskr.y) : (v * R.cskr.x - pv * R.cskr.y);
      const unsigned short ob = (unsigned short)(cvt_pk_bf16(o, 0.f) & 0xffffu);
      if (lane < 32) z[ZC_KRR + lane] = ob; }
    const int sub = lane & 7; const bool isx2 = (sub >> 1) & 1;
#pragma unroll
    for (int pass = 0; pass < 2; ++pass) {
        const bool act = (pass == 0) || (lane < 16);
        bf16_t* p = z + (pass == 0 ? ZC_CQ + 8 * lane : ZC_CK + 8 * (lane & 15));
        const float* gn = (pass == 0 ? cqn : ckn) + 8 * sub;
        const u32x4 w = (pass == 0) ? R.cq : R.ck; float v[8] = {bflo(w.x), bfhi(w.x), bflo(w.y), bfhi(w.y), bflo(w.z), bfhi(w.z), bflo(w.w), bfhi(w.w)};
        float s = 0.f;
#pragma unroll
        for (int e = 0; e < 8; ++e) s += v[e] * v[e];
        s += DPPF(s, 0xB1); s += DPPF(s, 0x4E); s += SHX(s, 4);
        const float r = __builtin_amdgcn_rsqf(s * (1.0f / 64.0f) + EPS);
        const float sc = (pass == 0) ? (0.125f * LOG2E) : 1.0f;
        float o[8];
#pragma unroll
        for (int e = 0; e < 8; ++e) { v[e] = v[e] * r * gn[e]; }
#pragma unroll
        for (int e = 0; e < 8; ++e) { const float pv = DPPF(v[e], 0x4E); o[e] = (isx2 ? (v[e] * R.cs[e].x + pv * R.cs[e].y) : (v[e] * R.cs[e].x - pv * R.cs[e].y)) * sc; }
        u32x4 ow; ow.x = cvt_pk_bf16(o[0], o[1]); ow.y = cvt_pk_bf16(o[2], o[3]); ow.z = cvt_pk_bf16(o[4], o[5]); ow.w = cvt_pk_bf16(o[6], o[7]);
        if (act) *(u32x4*)p = ow;
    }
}

#define MFMA32(a, b, c) __builtin_amdgcn_mfma_f32_32x32x16_bf16((a), (b), (c), 0, 0, 0)
__device__ __forceinline__ bf16x8 pack8(const float* p) { u32x4 w; w.x = cvt_pk_bf16(p[0], p[1]); w.y = cvt_pk_bf16(p[2], p[3]); w.z = cvt_pk_bf16(p[4], p[5]); w.w = cvt_pk_bf16(p[6], p[7]); return __builtin_bit_cast(bf16x8, w); }

__device__ __forceinline__ void dil_item(LAS unsigned char* lds, int item, const bf16_t* Z, bf16_t* OB, float* LSE, const float* biasT, int tid, int wid, int lane) {
    constexpr int KP = 72, KB = 64 * KP * 2, PAIRB = 2 * KB + 528;
    const int g = wid >> 1, hf = wid & 1, pt = tid & 127, q = lane & 31, hi = lane >> 5;
    const int rho_pi = (q & ~12) | ((q & 4) << 1) | ((q & 8) >> 1);
    const int nb = item * 4 + g, p = nb / 3072, rem = nb % 3072, h = rem / 768, blk = rem % 768;
    const int dl = (p == 0) ? 1 : (p == 1 ? 4 : 16);
    int S, sbase, k, bpr;
    if (blk < 256) { S = 8192; sbase = (blk >> 7) * 8192; k = blk & 127; bpr = 128 / dl; }
    else { const int b2 = blk - 256; S = 2048; sbase = NP + (b2 >> 5) * 2048; k = b2 & 31; bpr = 32 / dl; }
    const int r = k / bpr, n = k % bpr, L = 64 * bpr;
    LAS unsigned char* Kl = lds + g * PAIRB; LAS unsigned char* Vl = Kl + KB; LAS float* bl = (LAS float*)(Kl + 2 * KB);
    bl[pt] = biasT[(p * 129 + pt) * 4 + h]; if (pt == 0) bl[128] = biasT[(p * 129 + 128) * 4 + h];
    const int qi = 32 * hf + q; const int tq = sbase + (64 * n + qi) * dl + r;
    bf16x8 qf[4];
#pragma unroll
    for (int ks = 0; ks < 4; ++ks) qf[ks] = *(const bf16x8*)(Z + (size_t)tq * ZP + ZC_BQ + h * 64 + 16 * ks + 8 * hi);
    f32x16 oacc[2]; float zf_ = 0.f; asm volatile("" : "+v"(zf_));
#pragma unroll
    for (int i = 0; i < 16; ++i) { oacc[0][i] = zf_; oacc[1][i] = zf_; }
    float m_run = -INFINITY, l_run = 0.f;
    u32x4 kst[4], vst[2][2];
#define DIL_GLOAD(ktv) do { const int l0_ = 64 * (n + (ktv)); \
        _Pragma("unroll") for (int i_ = 0; i_ < 4; ++i_) { const int c_ = pt + 128 * i_, row_ = c_ >> 3, ch_ = c_ & 7, lk_ = l0_ + row_; kst[i_] = zero4(); \
            if (lk_ >= 0 && lk_ < L) kst[i_] = *(const u32x4*)(Z + (size_t)(sbase + lk_ * dl + r) * ZP + ZC_BK + h * 64 + 8 * ch_); } \
        _Pragma("unroll") for (int i_ = 0; i_ < 2; ++i_) { const int dch_ = (pt >> 5) + 4 * i_, kp2_ = pt & 31, lk_ = l0_ + 2 * kp2_; vst[i_][0] = zero4(); vst[i_][1] = zero4(); \
            if (lk_ >= 0 && lk_ < L) vst[i_][0] = *(const u32x4*)(Z + (size_t)(sbase + lk_ * dl + r) * ZP + ZC_BV + h * 64 + 8 * dch_); \
            if (lk_ + 1 >= 0 && lk_ + 1 < L) vst[i_][1] = *(const u32x4*)(Z + (size_t)(sbase + (lk_ + 1) * dl + r) * ZP + ZC_BV + h * 64 + 8 * dch_); } } while (0)
    DIL_GLOAD(0);
#pragma unroll 1
    for (int kti = 0; kti < 3; ++kti) {
        const int kt = (kti == 0) ? 0 : (kti == 1 ? -1 : 1); const int l0 = 64 * (n + kt);
#pragma unroll
        for (int i = 0; i < 4; ++i) { const int c = pt + 128 * i, row = c >> 3, ch = c & 7; *(LAS u32x4*)(Kl + (row * KP + 8 * ch) * 2) = kst[i]; }
#pragma unroll
        for (int i = 0; i < 2; ++i) { const int dch = (pt >> 5) + 4 * i, kp2 = pt & 31; LAS unsigned* vt = (LAS unsigned*)Vl;
#pragma unroll
            for (int e = 0; e < 8; ++e) { const unsigned a = vst[i][0][e >> 1], b = vst[i][1][e >> 1]; const unsigned w = (e & 1) ? ((a >> 16) | (b & 0xffff0000u)) : ((a & 0xffffu) | (b << 16));
                vt[(8 * dch + e) * (KP / 2) + kp2] = w; } }
        __syncthreads();
        if (kti == 0) DIL_GLOAD(-1); else if (kti == 1) DIL_GLOAD(1);
        f32x16 sacc[2];
#pragma unroll
        for (int kb = 0; kb < 2; ++kb) {
#pragma unroll
            for (int i = 0; i < 16; ++i) sacc[kb][i] = zf_;
#pragma unroll
            for (int ks = 0; ks < 4; ++ks) { const bf16x8 kf = *(const LAS bf16x8*)(Kl + ((32 * kb + rho_pi) * KP + 16 * ks + 8 * hi) * 2); sacc[kb] = MFMA32(kf, qf[ks], sacc[kb]); } }
        float mx = -INFINITY;
#pragma unroll
        for (int kb = 0; kb < 2; ++kb)
#pragma unroll
            for (int i = 0; i < 16; ++i) { const int kk = 32 * kb + 16 * (i >> 3) + 8 * hi + (i & 7); const int rel = 64 * kt + kk - qi, lk = l0 + kk;
                const bool ok = (rel >= -64) && (rel <= 64) && (lk >= 0) && (lk < L); const int bi = ok ? (rel + 64) : 64;
                const float s = ok ? (sacc[kb][i] * (0.125f * LOG2E) + bl[bi]) : -INFINITY; sacc[kb][i] = s; mx = fmaxf(mx, s); }
        mx = fmaxf(mx, SHX(mx, 32));
        const float m_new = fmaxf(m_run, mx), alpha = __builtin_amdgcn_exp2f(m_run - m_new); m_run = m_new;
        float ls = 0.f; float pr[2][16];
#pragma unroll
        for (int kb = 0; kb < 2; ++kb)
#pragma unroll
            for (int i = 0; i < 16; ++i) { const float e = __builtin_amdgcn_exp2f(sacc[kb][i] - m_new); pr[kb][i] = e; ls += e; }
        l_run = l_run * alpha + ls;
#pragma unroll
        for (int i = 0; i < 16; ++i) { oacc[0][i] *= alpha; oacc[1][i] *= alpha; }
#pragma unroll
        for (int kb = 0; kb < 2; ++kb)
#pragma unroll
            for (int s2 = 0; s2 < 2; ++s2) { const bf16x8 pf = pack8(&pr[kb][8 * s2]);
#pragma unroll
                for (int db = 0; db < 2; ++db) { const bf16x8 vf = *(const LAS bf16x8*)(Vl + ((32 * db + q) * KP + 32 * kb + 16 * s2 + 8 * hi) * 2); oacc[db] = MFMA32(vf, pf, oacc[db]); } }
        __syncthreads();
    }
#undef DIL_GLOAD
    const float lt = l_run + SHX(l_run, 32), inv = 1.0f / lt;
    bf16_t* orow = OB + ((size_t)p * M + tq) * 256 + h * 64;
#pragma unroll
    for (int db = 0; db < 2; ++db)
#pragma unroll
        for (int g4 = 0; g4 < 4; ++g4) { u32x2 w; w.x = cvt_pk_bf16(oacc[db][4 * g4] * inv, oacc[db][4 * g4 + 1] * inv); w.y = cvt_pk_bf16(oacc[db][4 * g4 + 2] * inv, oacc[db][4 * g4 + 3] * inv);
            *(u32x2*)(orow + 32 * db + 8 * g4 + 4 * hi) = w; }
    if (hi == 0) LSE[((size_t)p * M + tq) * 4 + h] = m_run + __builtin_amdgcn_logf(lt);
}

template <int DQK>
__device__ __forceinline__ void dense_item(LAS unsigned char* lds, const bf16_t* Q, int qp, const bf16_t* Kg, const bf16_t* Kg2, int kpitch, const bf16_t* Vg, int vp, bf16_t* O, int op, int nkeys,
                                           int tid, int wid, int lane) {
    constexpr int KP = DQK + 8, VP = 72, KBYTES = 64 * KP * 2, VBYTES = 64 * VP * 2, STAGE = KBYTES + VBYTES, NKS = DQK / 16, CH = DQK / 8, NKL = CH * 64 / 256;
    const int q = lane & 31, hi = lane >> 5;
    typedef __attribute__((address_space(1))) const bf16_t gbf;
    gbf* Kg_ = (gbf*)Kg; gbf* Kg2_ = (gbf*)Kg2; gbf* Vg_ = (gbf*)Vg; gbf* Q_ = (gbf*)Q;
    const int rho_pi = (q & ~12) | ((q & 4) << 1) | ((q & 8) >> 1);
    bf16x8 qf[NKS];
    { gbf* qrow = Q_ + (size_t)(wid * 32 + q) * qp + 8 * hi;
#pragma unroll
      for (int ks = 0; ks < NKS; ++ks) qf[ks] = *(const __attribute__((address_space(1))) bf16x8*)(qrow + 16 * ks); }
    f32x16 oacc[2]; float zf_ = 0.f; asm volatile("" : "+v"(zf_));
#pragma unroll
    for (int i = 0; i < 16; ++i) { oacc[0][i] = zf_; oacc[1][i] = zf_; }
    float m_run = -INFINITY, l_run = 0.f;
    u32x4 st[3];
    const int kp2 = tid & 31, dch = (tid >> 5) & 7, t2 = tid & 255;
#define DA_GLOAD(j) do { const int key0 = (j) * 64; \
        if (wid < 4) { gbf* vsrc = Vg_ + (size_t)(key0 + 2 * kp2) * vp + 8 * dch; st[0] = *(const __attribute__((address_space(1))) u32x4*)vsrc; st[1] = *(const __attribute__((address_space(1))) u32x4*)(vsrc + vp); } \
        else { _Pragma("unroll") for (int i_ = 0; i_ < NKL; ++i_) { const int c_ = t2 + 256 * i_, row_ = c_ / CH, ch_ = c_ % CH; st[i_] = *(const __attribute__((address_space(1))) u32x4*)((ch_ < 8 ? Kg_ + 8 * ch_ : Kg2_ + 8 * (ch_ - 8)) + (size_t)(key0 + row_) * kpitch); } } } while (0)
#define DA_LSTORE(s) do { LAS unsigned char* base_ = lds + (s) * STAGE; \
        if (wid < 4) { LAS unsigned* vt_ = (LAS unsigned*)(base_ + KBYTES); \
            _Pragma("unroll") for (int e_ = 0; e_ < 8; ++e_) { const unsigned a_ = st[0][e_ >> 1], b_ = st[1][e_ >> 1]; \
                const unsigned w_ = (e_ & 1) ? ((a_ >> 16) | (b_ & 0xffff0000u)) : ((a_ & 0xffffu) | (b_ << 16)); vt_[(8 * dch + e_) * (VP / 2) + kp2] = w_; } } \
        else { _Pragma("unroll") for (int i_ = 0; i_ < NKL; ++i_) { const int c_ = t2 + 256 * i_, row_ = c_ / CH, ch_ = c_ % CH; *(LAS u32x4*)(base_ + (row_ * KP + 8 * ch_) * 2) = st[i_]; } } } while (0)
    const int nt = nkeys / 64;
    f32x16 negm;
#pragma unroll
    for (int i = 0; i < 16; ++i) negm[i] = zf_;
#define DA_TILE(j, FIRST) do { \
        if ((j) + 1 < nt) DA_GLOAD((j) + 1); \
        LAS unsigned char* Kl = lds + ((j) & 1) * STAGE; LAS unsigned char* Vl = Kl + KBYTES; \
        f32x16 sacc[2]; bf16x8 kf[2][NKS]; \
        _Pragma("unroll") for (int kb = 0; kb < 2; ++kb) _Pragma("unroll") for (int ks = 0; ks < NKS; ++ks) kf[kb][ks] = *(const LAS bf16x8*)(Kl + ((32 * kb + rho_pi) * KP + 16 * ks + 8 * hi) * 2); \
        __builtin_amdgcn_sched_barrier(0); \
        _Pragma("unroll") for (int kb = 0; kb < 2; ++kb) { sacc[kb] = MFMA32(kf[kb][0], qf[0], negm); \
            _Pragma("unroll") for (int ks = 1; ks < NKS; ++ks) sacc[kb] = MFMA32(kf[kb][ks], qf[ks], sacc[kb]); } \
        bf16x8 vf[2][2][2]; \
        _Pragma("unroll") for (int kb = 0; kb < 2; ++kb) _Pragma("unroll") for (int s2 = 0; s2 < 2; ++s2) _Pragma("unroll") for (int db = 0; db < 2; ++db) \
            vf[kb][s2][db] = *(const LAS bf16x8*)(Vl + ((32 * db + q) * VP + 32 * kb + 16 * s2 + 8 * hi) * 2); \
        __builtin_amdgcn_sched_barrier(0); \
        float ls = 0.f; float pr[2][16]; \
        if (FIRST) { float mx = sacc[0][0]; \
            _Pragma("unroll") for (int i = 0; i < 16; ++i) { mx = fmaxf(mx, sacc[0][i]); mx = fmaxf(mx, sacc[1][i]); } \
            m_run = fmaxf(mx, SHX(mx, 32)); \
            _Pragma("unroll") for (int i = 0; i < 16; ++i) negm[i] = -m_run; \
            _Pragma("unroll") for (int kb = 0; kb < 2; ++kb) _Pragma("unroll") for (int i = 0; i < 16; ++i) { const float e = __builtin_amdgcn_exp2f(sacc[kb][i] - m_run); pr[kb][i] = e; ls += e; } \
        } else { \
            _Pragma("unroll") for (int kb = 0; kb < 2; ++kb) _Pragma("unroll") for (int i = 0; i < 16; ++i) { const float e = __builtin_amdgcn_exp2f(sacc[kb][i]); pr[kb][i] = e; ls += e; } \
            if (__builtin_amdgcn_ballot_w64(ls > 65536.0f) != 0ull) { \
                float d = (ls > 65536.0f) ? __builtin_amdgcn_logf(ls) : 0.f; d = fmaxf(d, SHX(d, 32)); \
                const float al = __builtin_amdgcn_exp2f(-d); m_run += d; ls *= al; l_run *= al; \
                _Pragma("unroll") for (int i = 0; i < 16; ++i) { pr[0][i] *= al; pr[1][i] *= al; oacc[0][i] *= al; oacc[1][i] *= al; negm[i] = -m_run; } \
            } \
        } \
        l_run += ls; \
        _Pragma("unroll") for (int kb = 0; kb < 2; ++kb) _Pragma("unroll") for (int s2 = 0; s2 < 2; ++s2) { const bf16x8 pf = pack8(&pr[kb][8 * s2]); \
            _Pragma("unroll") for (int db = 0; db < 2; ++db) oacc[db] = MFMA32(vf[kb][s2][db], pf, oacc[db]); } \
        if ((j) + 1 < nt) DA_LSTORE(((j) + 1) & 1); \
        __syncthreads(); } while (0)
    DA_GLOAD(0); DA_LSTORE(0);
    __syncthreads();
    DA_TILE(0, true);
    for (int j = 1; j < nt; ++j) DA_TILE(j, false);
#undef DA_TILE
#undef DA_GLOAD
#undef DA_LSTORE
    const float inv = 1.0f / (l_run + SHX(l_run, 32));
    bf16_t* orow = O + (size_t)(wid * 32 + q) * op;
#pragma unroll
    for (int db = 0; db < 2; ++db)
#pragma unroll
        for (int g4 = 0; g4 < 4; ++g4) { u32x2 w; w.x = cvt_pk_bf16(oacc[db][4 * g4] * inv, oacc[db][4 * g4 + 1] * inv); w.y = cvt_pk_bf16(oacc[db][4 * g4 + 2] * inv, oacc[db][4 * g4 + 3] * inv);
            *(u32x2*)(orow + 32 * db + 8 * g4 + 4 * hi) = w; }
}

struct EpiUq {
    static constexpr bool PERM = false, AFTER_DRAIN = false;
    bf16_t* Z; const f32x2v* tab;
    __device__ __forceinline__ void operator()(const f32x4 (&acc)[2][2][4][2], const pg8::Unit& u, int wr_, int wc_, int fr_, int fq_) const {
        int wr = wr_, wc = wc_; unsigned ones_ = ~0u; asm volatile("" : "+s"(wr), "+s"(wc), "+s"(ones_)); int ln_ = __builtin_amdgcn_mbcnt_hi(ones_, __builtin_amdgcn_mbcnt_lo(ones_, 0u)); int fr = ln_ & 15, fq = ln_ >> 4; (void)fr_; (void)fq_;
        const float qs = 0.10206207261596577f * LOG2E;
#pragma unroll
        for (int bj = 0; bj < 2; ++bj) {
            const int gidx = 8 * u.pn + 4 * bj + wc; if (gidx >= 12) continue;
            const bool rope = (gidx % 3) == 2; const int col = ZC_QA + 32 * gidx + 4 * fq;
#pragma unroll
            for (int ai = 0; ai < 2; ++ai)
#pragma unroll
                for (int m = 0; m < 4; ++m) { int frm = fr; asm volatile("" : "+v"(frm)); const int T = u.pm * 256 + ai * 128 + wr * 64 + m * 16 + frm; bf16_t* zr = Z + (size_t)T * ZP + col;
                    f32x4 x1 = acc[ai][bj][m][0], x2 = acc[ai][bj][m][1];
                    if (rope) { int t, S; tok_info(T, t, S); const f32x2v* cs = tab + t * 16 + 4 * fq; f32x4 o1, o2;
#pragma unroll
                        for (int e = 0; e < 4; ++e) { const f32x2v c = cs[e]; o1[e] = x1[e] * c.x - x2[e] * c.y; o2[e] = x2[e] * c.x + x1[e] * c.y; }
                        x1 = o1; x2 = o2; }
                    x1 = x1 * qs; x2 = x2 * qs;
                    u32x2 w; w.x = cvt_pk_bf16(x1[0], x1[1]); w.y = cvt_pk_bf16(x1[2], x1[3]); *(u32x2*)zr = w;
                    w.x = cvt_pk_bf16(x2[0], x2[1]); w.y = cvt_pk_bf16(x2[2], x2[3]); *(u32x2*)(zr + 16) = w; asm volatile("" : "+v"(fr) : "v"(w.x), "v"(w.y) : "memory"); }
        }
    }
};
struct EpiUkv {
    static constexpr bool PERM = false, AFTER_DRAIN = false;
    bf16_t* Z; bf16_t* VA;
    __device__ __forceinline__ void operator()(const f32x4 (&acc)[2][2][4][2], const pg8::Unit& u, int wr_, int wc_, int fr_, int fq_) const {
        int wr = wr_, wc = wc_; unsigned ones_ = ~0u; asm volatile("" : "+s"(wr), "+s"(wc), "+s"(ones_)); int ln_ = __builtin_amdgcn_mbcnt_hi(ones_, __builtin_amdgcn_mbcnt_lo(ones_, 0u)); int fr = ln_ & 15, fq = ln_ >> 4; (void)fr_; (void)fq_;
#pragma unroll
        for (int bj = 0; bj < 2; ++bj) { const int head = 2 * u.pn + bj;
#pragma unroll
            for (int ai = 0; ai < 2; ++ai)
#pragma unroll
                for (int m = 0; m < 4; ++m) { const int T = u.pm * 256 + ai * 128 + wr * 64 + m * 16 + fr;
                    bf16_t* dst = (wc < 2) ? (Z + (size_t)T * ZP + ZC_KA + head * 96 + 32 * wc + 4 * fq) : (VA + (size_t)T * 256 + head * 64 + 32 * (wc - 2) + 4 * fq);
#pragma unroll
                    for (int n = 0; n < 2; ++n) { const f32x4 x = acc[ai][bj][m][n]; u32x2 w; w.x = cvt_pk_bf16(x[0], x[1]); w.y = cvt_pk_bf16(x[2], x[3]); *(u32x2*)(dst + 16 * n) = w; } } }
    }
};
struct EpiUp {
    static constexpr bool PERM = false, AFTER_DRAIN = false;
    bf16_t* Gout; const float* cw; const float* cb;
    __device__ __forceinline__ void operator()(const f32x4 (&acc)[2][2][4][2], const pg8::Unit& u, int wr_, int wc_, int fr_, int fq_) const {
        int wr = wr_, wc = wc_; unsigned ones_ = ~0u; asm volatile("" : "+s"(wr), "+s"(wc), "+s"(ones_)); int ln_ = __builtin_amdgcn_mbcnt_hi(ones_, __builtin_amdgcn_mbcnt_lo(ones_, 0u)); int fr = ln_ & 15, fq = ln_ >> 4; (void)fr_; (void)fq_;
#pragma unroll
        for (int n = 0; n < 2; ++n) {
            int frm = fr; asm volatile("" : "+v"(frm));
            const int jc = 128 * u.pn + 32 * wc + 16 * n + 4 * fq;
            const int Tb = 252 * u.pm + 126 * wr - 1 + frm;
            float mu[8], md[8];
#pragma unroll
            for (int mm = 0; mm < 8; ++mm) { const int T = Tb + 16 * mm; int t, S; tok_info(T < 0 ? 0 : (T >= M ? M - 1 : T), t, S); mu[mm] = (t == 0) ? 0.f : 1.f; md[mm] = (t == S - 1) ? 0.f : 1.f; }
            float gl[8][4];
#pragma unroll
            for (int bj = 0; bj < 2; ++bj) {
                const int c = jc + 2816 * bj;
                const f32x4 w0 = *(const f32x4*)(cw + c), w1 = *(const f32x4*)(cw + 5632 + c), w2 = *(const f32x4*)(cw + 2 * 5632 + c), bb = *(const f32x4*)(cb + c);
#pragma unroll
                for (int e = 0; e < 4; ++e) {
                    float ru[8], rd[8], xv[8];
#pragma unroll
                    for (int mm = 0; mm < 8; ++mm) xv[mm] = acc[mm >> 2][bj][mm & 3][n][e];
                    asm volatile("" : "+v"(xv[0]), "+v"(xv[1]), "+v"(xv[2]), "+v"(xv[3]), "+v"(xv[4]), "+v"(xv[5]), "+v"(xv[6]), "+v"(xv[7]), "+v"(frm));
#pragma unroll
                    for (int mm = 0; mm < 8; ++mm) { ru[mm] = DPPF(xv[mm], 0x121); rd[mm] = DPPF(xv[mm], 0x12F); }
#pragma unroll
                    for (int mm = 0; mm < 8; ++mm) {
                        const float up = (frm == 0) ? ru[mm > 0 ? mm - 1 : 0] : ru[mm];
                        const float dn = (frm == 15) ? rd[mm < 7 ? mm + 1 : 7] : rd[mm];
                        const float cv = bb[e] + w1[e] * xv[mm] + (w0[e] * up) * mu[mm] + (w2[e] * dn) * md[mm];
                        if (bj == 0) { const float uu = 0.7978845608028654f * (cv + 0.044715f * cv * cv * cv);
                            gl[mm][e] = cv * __builtin_amdgcn_rcpf(1.0f + __builtin_amdgcn_exp2f(-2.8853900817779268f * uu)); }
                        else gl[mm][e] = gl[mm][e] * cv;
                    }
                    asm volatile("" : "+v"(frm) : "v"(gl[0][e]), "v"(gl[1][e]), "v"(gl[2][e]), "v"(gl[3][e]), "v"(gl[4][e]), "v"(gl[5][e]), "v"(gl[6][e]), "v"(gl[7][e]));
                }
            }
#pragma unroll
            for (int mm = 0; mm < 8; ++mm) { const int lr = 16 * mm + frm, T = Tb + 16 * mm;
                if (lr >= 1 && lr <= 126 && T < M) { u32x2 w; w.x = cvt_pk_bf16(gl[mm][0], gl[mm][1]); w.y = cvt_pk_bf16(gl[mm][2], gl[mm][3]); *(u32x2*)(Gout + (size_t)T * 2816 + jc) = w; } }
            asm volatile("" ::: "memory"); __builtin_amdgcn_sched_barrier(0);
        }
    }
};
}

using namespace mk;
#define XB_TMO      128
#define XB_XCNT(j)  (256  + 64 * (j))
#define XB_XSUB(j)  (1280 + 64 * (j))
#define XB_XGEN(j)  (2304 + 64 * (j))
#define XB_TOP      3328
#define XB_TOPGEN   3392
#define XCD_BAR_WORDS 3456
#define XB_SPIN_CAP (1u << 18)

__device__ __forceinline__ unsigned xb_ld(unsigned* p)              { return __hip_atomic_load(p, __ATOMIC_RELAXED, __HIP_MEMORY_SCOPE_AGENT); }
__device__ __forceinline__ unsigned xb_add(unsigned* p, unsigned v) { return __hip_atomic_fetch_add(p, v, __ATOMIC_RELAXED, __HIP_MEMORY_SCOPE_AGENT); }
__device__ __forceinline__ unsigned xb_xcc_id() { return (unsigned)__builtin_amdgcn_s_getreg((3 << 11) | 20) & 0xFu; }
#define XB_SPIN(cond, bar) do { unsigned _sp = 0; while (cond) { __builtin_amdgcn_s_sleep(1); \
    if ((++_sp & 255u) == 0u) { if (xb_ld(&(bar)[XB_TMO])) break; if (_sp > XB_SPIN_CAP) { atomicAdd(&(bar)[XB_TMO], 1u); break; } } } } while (0)

struct XcdBarrier {
    unsigned* bar; unsigned x;
    volatile LAS unsigned* st;
};

__device__ __forceinline__ XcdBarrier xcd_barrier_post(unsigned* bar, volatile LAS unsigned* st, bool leader) {
    XcdBarrier b; b.bar = bar; b.x = xb_xcc_id(); b.st = st;
    if (leader) (void)xb_add(&bar[XB_XCNT(b.x)], 1u);
    return b;
}
__device__ __forceinline__ void xcd_barrier_complete(unsigned* bar, unsigned x, unsigned& nloc, unsigned& nx) {
    const unsigned G = gridDim.x * gridDim.y * gridDim.z;
    unsigned sum, cnt, mine, sp = 0u;
    for (;;) {
        sum = 0u; cnt = 0u; mine = 0u;
#pragma unroll
        for (unsigned j = 0; j < 16; ++j) { const unsigned c = xb_ld(&bar[XB_XCNT(j)]); sum += c; cnt += (c > 0u) ? 1u : 0u; mine = (j == x) ? c : mine; }
        if (sum == G) break;
        __builtin_amdgcn_s_sleep(1);
        if ((++sp & 255u) == 0u) { if (xb_ld(&bar[XB_TMO])) break; if (sp > XB_SPIN_CAP) { atomicAdd(&bar[XB_TMO], 1u); break; } }
    }
    nloc = mine > 0u ? mine : 1u; nx = cnt > 0u ? cnt : 1u;
}

__device__ __forceinline__ void xcd_barrier(const XcdBarrier& b, bool leader) {
    asm volatile("s_waitcnt vmcnt(0)" ::: "memory");
    __syncthreads();
    if (leader) {
        unsigned* bar = b.bar;
        __builtin_amdgcn_s_waitcnt(0);
        unsigned nloc = b.st[0], nx = b.st[1];
        if (nloc == 0u) { xcd_barrier_complete(bar, b.x, nloc, nx); b.st[0] = nloc; b.st[1] = nx; }
        const unsigned old = xb_add(&bar[XB_XSUB(b.x)], 1u);
        const unsigned gen = old / nloc;
        if (old + 1u == (gen + 1u) * nloc) {
            __builtin_amdgcn_fence(__ATOMIC_RELEASE, "agent");
            asm volatile("s_waitcnt vmcnt(0)" ::: "memory");
            const unsigned og = xb_add(&bar[XB_TOP], 1u);
            const unsigned tg = og / nx;
            if (og + 1u == (tg + 1u) * nx) xb_add(&bar[XB_TOPGEN], 1u);
            else XB_SPIN(xb_ld(&bar[XB_TOPGEN]) == tg, bar);
            __builtin_amdgcn_fence(__ATOMIC_ACQUIRE, "agent");
            xb_add(&bar[XB_XGEN(b.x)], 1u);
            asm volatile("s_waitcnt vmcnt(0)" ::: "memory");
        } else {
            XB_SPIN(xb_ld(&bar[XB_XGEN(b.x)]) == gen, bar);
            __builtin_amdgcn_fence(__ATOMIC_ACQUIRE, "agent");
            asm volatile("s_waitcnt vmcnt(0)" ::: "memory");
        }
    }
    __syncthreads();
}

template <int PH>
__device__ __forceinline__ void run_phase(const Args& a, LAS unsigned char* lds, int wid0, int G0, int bid0) {
    LAS int* sh_item = (LAS int*)(lds + 143360);
        int G = G0, bid = bid0, wid = wid0; asm volatile("" : "+s"(G), "+s"(bid), "+s"(wid));
        const int gw = bid * NWAVES + wid, NGW = G * NWAVES;
#define FRESH_LANE() unsigned ones_ = ~0u; asm volatile("" : "+s"(ones_)); int lane = __builtin_amdgcn_mbcnt_hi(ones_, __builtin_amdgcn_mbcnt_lo(ones_, 0u)); const int tid = wid * 64 + lane; (void)tid
        unsigned char* ws = a.ws; asm volatile("" : "+s"(ws));
#define ctl ((unsigned*)(ws + WS_CTL))
#define PT ((const float* const*)(ws + WS_CTL + 1024))
#define tab ((const f32x2v*)(ws + WS_TAB))
#define biasT ((const float*)(ws + WS_BIAS))
#define Wb ((bf16_t*)(ws + WS_W))
#define XB ((bf16_t*)(ws + WS_XB) + (size_t)256 * 1024)
#define Z ((bf16_t*)(ws + WS_Z))
#define VA ((bf16_t*)(ws + WS_VA))
#define OB ((bf16_t*)(ws + WS_OB))
#define LSE ((float*)(ws + WS_LSE))
#define MIX Z
#define GB Z
#define X (a.out)
        if constexpr (PH == 0) { FRESH_LANE(); for (int rep = 0; rep < REP_PRO; ++rep) phase_prologue(a, lds, G, bid, tid, wid, lane); return; }
        constexpr int l = (PH > 0 ? PH - 1 : 0) / 9, k = (PH > 0 ? PH - 1 : 0) % 9;
#define Wl (Wb + (size_t)l * WL_STRIDE)
        if constexpr (PH == 0) { } else if constexpr (k == 0) { FRESH_LANE();
            pg8::Gemm g{XB, Wl + OFF_WIN, M, 2048, 1024, 1024}; pg8::StaticOrder S; S.init(M, 2048, G, bid);
            pg8::EpiBf16<0> E{Z, ZP, nullptr, 0, 0, 1.f};
            for (int rep = 0; rep < REP_GIN; ++rep)
            pg8::gemm_phase<pg8::EpiBf16<0>, pg8::StaticOrder, true, true>(lds, g, S, E, tid);
        } else if constexpr (k == 1) { FRESH_LANE();
            { const float* cqn = PT[10] + l * 64; const float* ckn = PT[11] + l * 64;
              for (int T = gw; T < M; T += 2 * NGW) { TokRegs R0, R1; const int T1 = (T + NGW < M) ? T + NGW : T;
                  token_load(R0, Z, tab, T, lane); token_load(R1, Z, tab, T1, lane);
                  token_finish(R0, Z, cqn, ckn, T, lane); if (T1 != T) token_finish(R1, Z, cqn, ckn, T1, lane); } }
            __syncthreads();
            for (int rep = 0; rep < REP_DIL; ++rep)
            for (int it = bid; it < 2304; it += G) dil_item(lds, it, Z, OB, LSE, biasT, tid, wid, lane);
        } else if constexpr (k == 2) { FRESH_LANE();
            { pg8::Gemm g{Z + ZC_AQ, Wl + OFF_WUQ, M, 512, 256, ZP}; pg8::StaticOrder S; S.init(M, 512, G, bid);
              EpiUq E{Z, tab}; pg8::gemm_phase<EpiUq, pg8::StaticOrder, true, true>(lds, g, S, E, tid); }
            { unsigned ones2_ = ~0u; asm volatile("" : "+s"(ones2_)); int lane2 = __builtin_amdgcn_mbcnt_hi(ones2_, __builtin_amdgcn_mbcnt_lo(ones2_, 0u));
              pg8::Gemm g{Z + ZC_AKV, Wl + OFF_WUKV, M, 512, 128, ZP}; pg8::StaticOrder S; S.init(M, 512, G, (bid + G / 2) % G);
              EpiUkv E{Z, VA}; pg8::gemm_phase<EpiUkv, pg8::StaticOrder, true, true>(lds, g, S, E, wid * 64 + lane2); }
        } else if constexpr (k == 3) { FRESH_LANE();
            for (int rep = 0; rep < REP_ATT; ++rep) {
            const int xme = (int)(xb_xcc_id() & 7u);
            for (int qi = 0; qi < 8; ++qi) {
                const int xq = (xme + qi) & 7;
                for (;;) {
                    if (tid == 0) *sh_item = (int)atomicAdd(ctl + 64 + (l * 2 + rep) * 8 + xq, 1u);
                    __syncthreads();
                    const int it = __builtin_amdgcn_readfirstlane(*sh_item);
                    __syncthreads();
                    if (it >= 384) break;
                    if (it >= 288) {
                        for (int tt = 0; tt < 8; ++tt) { const int T = 6144 * xq + 64 * (it - 288) + 8 * wid + tt;
                const int h = lane >> 4, d4 = (lane & 15) * 4;
                float ls[3], mx = -INFINITY;
#pragma unroll
                for (int p = 0; p < 3; ++p) { ls[p] = LSE[((size_t)p * M + T) * 4 + h]; mx = fmaxf(mx, ls[p]); }
                float den = 0.f; f32x4 o = (f32x4){0.f, 0.f, 0.f, 0.f};
#pragma unroll
                for (int p = 0; p < 3; ++p) { const float w = __builtin_amdgcn_exp2f(ls[p] - mx); den += w; const u32x2 v = *(const u32x2*)(OB + ((size_t)p * M + T) * 256 + h * 64 + d4);
                    o = o + (f32x4){bflo(v.x), bfhi(v.x), bflo(v.y), bfhi(v.y)} * w; }
                const float inv = 1.0f / den; u32x2 w; w.x = cvt_pk_bf16(o[0] * inv, o[1] * inv); w.y = cvt_pk_bf16(o[2] * inv, o[3] * inv);
                *(u32x2*)(XB + (size_t)T * 1024 + 256 + h * 64 + d4) = w;
                        }
                        continue;
                    }
                    int b, h, qb, nk; size_t r0; bool isA;
                    if (it < 32) { b = xq >> 2; h = xq & 3; qb = it; r0 = (size_t)b * 8192; nk = 8192; isA = true; }
                    else if (it < 96) { const int i2 = it - 32, pc = 2 * xq + (i2 >> 5); b = pc >> 3; h = pc & 7; qb = i2 & 31; r0 = (size_t)b * 8192; nk = 8192; isA = false; }
                    else if (it < 160) { const int i2 = it - 96, pa = 8 * xq + (i2 >> 3); b = pa >> 2; h = pa & 3; qb = i2 & 7; r0 = (size_t)NP + (size_t)b * 2048; nk = 2048; isA = true; }
                    else { const int i2 = it - 160, pc = 16 * xq + (i2 >> 3); b = pc >> 3; h = pc & 7; qb = i2 & 7; r0 = (size_t)NP + (size_t)b * 2048; nk = 2048; isA = false; }
                    const size_t rq = r0 + (size_t)qb * 256;
                    if (isA) dense_item<96>(lds, Z + rq * ZP + ZC_QA + h * 96, ZP, Z + r0 * ZP + ZC_KA + h * 96, Z + r0 * ZP + ZC_KRR, ZP, VA + r0 * 256 + h * 64, 256, XB + rq * 1024 + h * 64, 1024, nk, tid, wid, lane);
                    else dense_item<64>(lds, Z + rq * ZP + ZC_CQ + h * 64, ZP, Z + r0 * ZP + ZC_CK + (h >> 2) * 64, nullptr, ZP, Z + r0 * ZP + ZC_CV + (h >> 2) * 64, ZP, XB + rq * 1024 + 512 + h * 64, 1024, nk, tid, wid, lane);
                }
            } }
        } else if constexpr (k == 4) { FRESH_LANE();
            pg8::Gemm g{XB, Wl + OFF_WOUT, M, 1024, 1024, 1024}; pg8::StaticOrder S; S.init(M, 1024, G, bid);
            pg8::EpiBf16<0> E{MIX, 1024, nullptr, 0, 0, 1.f};
            pg8::gemm_phase<pg8::EpiBf16<0>, pg8::StaticOrder, true, true>(lds, g, S, E, tid);
        } else if constexpr (k == 5) { FRESH_LANE();
            phase_resnorm(MIX, PT[4] + l * 1024, X, XB, G, bid, wid, lane);
        } else if constexpr (k == 6) { FRESH_LANE();
            pg8::Gemm g{XB - 1024, Wl + OFF_WUP, 196 * 256, 5632, 1024, 1024}; pg8::StaticOrder S; S.init(196 * 256, 5632, G, bid);
            EpiUp E{GB, PT[16] + (size_t)l * 3 * 5632, PT[17] + (size_t)l * 5632};
            for (int rep = 0; rep < REP_GUP; ++rep)
            pg8::gemm_phase<EpiUp, pg8::StaticOrder, true, true, true>(lds, g, S, E, tid);
        } else if constexpr (k == 7) { FRESH_LANE();
            pg8::Gemm g{GB, Wl + OFF_WDN, M, 1024, 2816, 2816}; pg8::StaticOrder S; S.init(M, 1024, G, bid);
            pg8::EpiBf16<0> E{XB, 1024, nullptr, 0, 0, 1.f};
            for (int rep = 0; rep < REP_GDN; ++rep)
            pg8::gemm_phase<pg8::EpiBf16<0>, pg8::StaticOrder, true, true>(lds, g, S, E, tid);
        } else { FRESH_LANE();
            phase_resnorm(XB, PT[14] + l * 1024, X, XB, G, bid, wid, lane);
        }
}
template <int PH>
__device__ __forceinline__ void run_all(const Args& a, LAS unsigned char* lds, cg::grid_group& grid, int wid0, int G0, int bid0) {
    if (a.ph_lo <= PH && PH < a.ph_hi) {
        if (PH > a.ph_lo) {
            unsigned ones_ = ~0u; asm volatile("" : "+s"(ones_)); const int lane_ = __builtin_amdgcn_mbcnt_hi(ones_, __builtin_amdgcn_mbcnt_lo(ones_, 0u));
            const bool leader = (wid0 == 0) && (lane_ == 0);
            unsigned* barw = (unsigned*)(a.ws + WS_CTL + 65536); volatile LAS unsigned* stw = (volatile LAS unsigned*)(lds + 143360 + 64);
            if constexpr (PH == 1) { grid.sync(); (void)xcd_barrier_post(barw, stw, leader); }
            else { XcdBarrier xb_; xb_.bar = barw; xb_.x = xb_xcc_id(); xb_.st = stw;
                for (int rep_ = 0; rep_ < REP_BAR; ++rep_) xcd_barrier(xb_, leader); }
        }
        run_phase<PH>(a, lds, wid0, G0, bid0);
    }
    if constexpr (PH + 1 < NPH) run_all<PH + 1>(a, lds, grid, wid0, G0, bid0);
}
__global__ void __launch_bounds__(512) mk_fwd(Args a) {
    extern __shared__ __attribute__((aligned(16))) unsigned char lds_raw[];
    LAS unsigned char* lds = (LAS unsigned char*)lds_raw;
    cg::grid_group grid = cg::this_grid();
    const int wid0 = __builtin_amdgcn_readfirstlane(threadIdx.x >> 6);
    const int G0 = gridDim.x, bid0 = blockIdx.x;
    if (threadIdx.x < 2) ((LAS unsigned*)(lds + 143360 + 64))[threadIdx.x] = 0u;
    __syncthreads();
    run_all<0>(a, lds, grid, wid0, G0, bid0);
}

extern "C" void kernel_launch(void* const* d_in, const int* in_sizes, int n_in, void* d_out, int out_size, void* d_ws, size_t ws_size, hipStream_t stream) {
    static int grid = 0;
    if (grid == 0) {
        if (n_in != 19 || out_size != M * D || ws_size < WS_END) { fprintf(stderr, "kernel_launch: unexpected shapes (n_in %d out %d ws %zu)\n", n_in, out_size, ws_size); grid = -1; return; }
        int dev = 0, cus = 0, per_cu = 0;
        hipGetDevice(&dev); hipDeviceGetAttribute(&cus, hipDeviceAttributeMultiprocessorCount, dev);
        if (hipFuncSetAttribute((const void*)mk_fwd, hipFuncAttributeMaxDynamicSharedMemorySize, LDS_BYTES) != hipSuccess) { fprintf(stderr, "kernel_launch: hipFuncSetAttribute failed\n"); grid = -1; return; }
        if (hipOccupancyMaxActiveBlocksPerMultiprocessor(&per_cu, (const void*)mk_fwd, 512, LDS_BYTES) != hipSuccess || per_cu < 1) { fprintf(stderr, "kernel_launch: occupancy query says %d\n", per_cu); per_cu = 1; }
        (void)hipGetLastError();
        grid = cus * per_cu;
    }
    if (grid < 0) return;
    Args a{};
    for (int i = 0; i < 19; ++i) a.in[i] = (const float*)d_in[i];
    a.out = (float*)d_out; a.ws = (unsigned char*)d_ws;
#ifdef MK_MULTI
    for (int ph = 0; ph < NPH; ++ph) { a.ph_lo = ph; a.ph_hi = ph + 1; hipLaunchKernelGGL(mk_fwd, dim3(grid), dim3(512), LDS_BYTES, stream, a); }
#else
    a.ph_lo = 0; a.ph_hi = NPH;
    void* args[] = {&a};
    hipError_t e = hipLaunchCooperativeKernel((const void*)mk_fwd, dim3(grid), dim3(512), args, LDS_BYTES, stream);
    if (e != hipSuccess) fprintf(stderr, "kernel_launch: cooperative launch failed: %s (grid %d)\n", hipGetErrorString(e), grid);
#endif
}
```

```cpp
#include <hip/hip_runtime.h>
#include <hip/hip_cooperative_groups.h>
#include <cstdio>
#include <cstdint>
namespace cg = cooperative_groups;
namespace pg8 {
#define PG8_LAS __attribute__((address_space(3)))
typedef unsigned short bf16_t;
typedef short bf16x8 __attribute__((ext_vector_type(8)));
typedef float f32x4 __attribute__((ext_vector_type(4)));
typedef unsigned u32x4 __attribute__((ext_vector_type(4)));
constexpr int BM = 256, BK = 64, HALF = 128, HTB = HALF * BK * 2  , STAGE_BYTES = 8 * HTB, NXCD = 8, WGM = 8;

__host__ __device__ __forceinline__ int lds_byte(int r, int c) { const int st = (r >> 4) * 2 + (c >> 5), rr = r & 15, cc = c & 31, ob = rr * 64 + cc * 2; return st * 1024 + (ob ^ (((ob >> 9) & 1) << 5)); }
__host__ __device__ __forceinline__ void stage_rc(int b, int& R, int& C) { const int st = b / 1024, sb = b % 1024, swz = sb ^ (((sb >> 9) & 1) << 5); R = (st >> 1) * 16 + swz / 64; C = (st & 1) * 32 + (swz % 64) / 2; }
__host__ __device__ __forceinline__ int perm32(int rho) { const int n = rho >> 4, i = rho & 15; return 8 * (i >> 2) + 4 * n + (i & 3); }

struct Unit { int pm, pn; };
struct Gemm { const bf16_t* A; const bf16_t* Bt; int M, N, K, lda; };

struct StaticOrder {
    int nM, nN, nwg, G, c;
    __host__ __device__ void init(int M, int N, int G_, int c_) { nM = M / BM; nN = N / BM; nwg = nM * nN; G = G_; c = c_; }
    __host__ __device__ bool next(int i, Unit& u) const {
        const long L = (long)i * G + c; if (L >= nwg) return false;
        int wgid = (int)L; { const int q = nwg / NXCD, r = nwg % NXCD, xcd = wgid % NXCD, off = wgid / NXCD; wgid = (xcd < r ? xcd * (q + 1) : r * (q + 1) + (xcd - r) * q) + off; }
        const int nig = WGM * nN, gid = wgid / nig, fm = gid * WGM, gsz = (nM - fm) < WGM ? (nM - fm) : WGM;
        u.pm = fm + ((wgid % nig) % gsz); u.pn = (wgid % nig) / gsz; return true;
    }
    __device__ __forceinline__ void a_ready(const Unit&) const {}
    __device__ __forceinline__ void done(const Unit&) const {}
};

__device__ __forceinline__ unsigned cvt_pk_bf16(float lo, float hi) { unsigned r; asm volatile("v_cvt_pk_bf16_f32 %0, %1, %2" : "=v"(r) : "v"(lo), "v"(hi)); return r; }
typedef float f32x2 __attribute__((ext_vector_type(2)));
__device__ __forceinline__ f32x2 gelu_pk(f32x2 v) {
    const f32x2 av = __builtin_elementwise_abs(v), d = av * 0.2316418882f + 1.0f;
    f32x2 t; t.x = __builtin_amdgcn_rcpf(d.x); t.y = __builtin_amdgcn_rcpf(d.y);
    f32x2 q = t * 0.5307027145f + (-0.7265760135f); q = q * t + 0.7107068705f; q = q * t + (-0.142248368f); q = q * t + 0.127414796f; q = q * t;
    const f32x2 s = (v * v) * (-0.72134752044f);
    f32x2 e; e.x = __builtin_amdgcn_exp2f(s.x); e.y = __builtin_amdgcn_exp2f(s.y);
    const f32x2 m = v * (q * e), r = v - m;
    f32x2 o; o.x = v.x < 0.f ? m.x : r.x; o.y = v.y < 0.f ? m.y : r.y; return o;
}

template <int ACT  > struct EpiBf16 {
    static constexpr bool PERM = true, AFTER_DRAIN = false; static_assert(ACT == 0 || ACT == 1, "EpiBf16: ACT is 0 (none) or 1 (gelu_pk)");
    bf16_t* O; int ldc; const float* bias; int split_cols; size_t split_stride; float scale0;
    __device__ __forceinline__ void operator()(const f32x4 (&acc)[2][2][4][2], const Unit& u, int wr, int wc, int fr, int fq) const {
        const int row0 = u.pm * BM + wr * 64 + fr; int colt = u.pn * BM; bf16_t* base = O;
        float sc = 1.f; if (split_cols) { const int t = colt / split_cols; base += (size_t)t * split_stride; colt -= t * split_cols; if (t == 0) sc = scale0; }
        const int col0 = colt + wc * 32 + 8 * fq, bcol0 = u.pn * BM + wc * 32 + 8 * fq;
        f32x4 bv[2][2];
#pragma unroll
        for (int bj = 0; bj < 2; ++bj)
#pragma unroll
            for (int n = 0; n < 2; ++n) bv[bj][n] = bias ? *(const f32x4*)(bias + bcol0 + bj * HALF + 4 * n) : (f32x4){0.f, 0.f, 0.f, 0.f};
#pragma unroll
        for (int ai = 0; ai < 2; ++ai)
#pragma unroll
            for (int m = 0; m < 4; ++m) { bf16_t* rowp = base + (size_t)(row0 + ai * HALF + m * 16) * ldc + col0;
#pragma unroll
                for (int bj = 0; bj < 2; ++bj) { f32x4 v0 = acc[ai][bj][m][0] + bv[bj][0], v1 = acc[ai][bj][m][1] + bv[bj][1];
                    if (ACT == 1) { f32x2 a = gelu_pk((f32x2){v0[0], v0[1]}), b = gelu_pk((f32x2){v0[2], v0[3]}), c = gelu_pk((f32x2){v1[0], v1[1]}), d = gelu_pk((f32x2){v1[2], v1[3]});
                        v0 = (f32x4){a.x, a.y, b.x, b.y}; v1 = (f32x4){c.x, c.y, d.x, d.y}; }
                    v0 = v0 * sc; v1 = v1 * sc; u32x4 w; w.x = cvt_pk_bf16(v0[0], v0[1]); w.y = cvt_pk_bf16(v0[2], v0[3]); w.z = cvt_pk_bf16(v1[0], v1[1]); w.w = cvt_pk_bf16(v1[2], v1[3]);
                    *(u32x4*)(rowp + bj * HALF) = w; } }
    }
};
template <class Epi, class Sched, bool ALIGN_EPI = false, bool SP2 = false, bool OVL = false>
__device__ __forceinline__ void gemm_phase(PG8_LAS unsigned char* lds, const Gemm g, const Sched& S, const Epi& E, int tid_l) {
    const int tid = tid_l, wid = __builtin_amdgcn_readfirstlane(tid >> 6), lane = tid & 63, wr = wid >> 2, wc = wid & 3, fr = lane & 15, fq = lane >> 4;
    const int K = g.K, nt = K / BK;
    unsigned voffA[2], voffB[2];
#pragma unroll
    for (int i = 0; i < 2; ++i) { int R, C; stage_rc(tid * 16 + i * 8192, R, C); const int Rb = Epi::PERM ? ((R & ~31) + perm32(R & 31)) : R;
        voffA[i] = (unsigned)((OVL ? (R + 62 * (R >> 6)) : R) * g.lda + C) * 2u; voffB[i] = (unsigned)(Rb * K + C) * 2u; }
    const size_t kstep = (size_t)(BK * 2);
    const size_t hstepA = (size_t)(OVL ? 64 : 128) * g.lda * 2, hstepB = (size_t)HALF * K * 2;
    const size_t tstepA = (size_t)(OVL ? 252 : 256) * g.lda * 2, tstepB = 2 * hstepB;
    const unsigned ldsw = (unsigned)wid * 1024u;
    const int aoff = lds_byte(wr * 64 + fr, fq * 8), boff = lds_byte(wc * 32 + fr, fq * 8);
#define PG8_SA(b, h) (((b) * 2 + (h)) * HTB)
#define PG8_SB(b, h) ((4 + (b) * 2 + (h)) * HTB)
#define PG8_STAGE(bufoff, gbase, voff) do { const char* gb_ = (const char*)(gbase); asm volatile("" : "+s"(gb_)); _Pragma("unroll") for (int _i = 0; _i < 2; ++_i) \
        __builtin_amdgcn_global_load_lds((const unsigned*)(gb_ + (voff)[_i]), (PG8_LAS unsigned*)(lds + (bufoff) + ldsw + _i * 8192), 16, 0, 0); } while (0)
#define PG8_LDA(dst, b, h) do { _Pragma("unroll") for (int m = 0; m < 4; ++m) _Pragma("unroll") for (int k = 0; k < 2; ++k) dst[m][k] = *(const PG8_LAS bf16x8*)(lds + PG8_SA(b, h) + aoff + m * 2048 + k * 1024); } while (0)
#define PG8_LDB(dst, b, h) do { _Pragma("unroll") for (int n = 0; n < 2; ++n) _Pragma("unroll") for (int k = 0; k < 2; ++k) dst[n][k] = *(const PG8_LAS bf16x8*)(lds + PG8_SB(b, h) + boff + n * 2048 + k * 1024); } while (0)
#define PG8_MMA(ai, bj, At, Bt) do { __builtin_amdgcn_s_setprio(1); _Pragma("unroll") for (int m = 0; m < 4; ++m) _Pragma("unroll") for (int n = 0; n < 2; ++n) _Pragma("unroll") for (int k = 0; k < 2; ++k) \
        acc[ai][bj][m][n] = __builtin_amdgcn_mfma_f32_16x16x32_bf16(Bt[n][k], At[m][k], acc[ai][bj][m][n], 0, 0, 0); __builtin_amdgcn_s_setprio(0); } while (0)
#define PG8_WAIT_V(n) asm volatile("s_waitcnt vmcnt(" #n ")" ::: "memory")
#define PG8_WAIT_L(n) asm volatile("s_waitcnt lgkmcnt(" #n ")" ::: "memory")
#define PG8_BAR __builtin_amdgcn_s_barrier()
#define PG8_SCHED __builtin_amdgcn_sched_barrier(0)
    Unit cur, nxt; int ui = 0;
    if (!S.next(0, cur)) return;
    f32x4 acc[2][2][4][2];
    float zf_ = 0.f; asm volatile("" : "+v"(zf_));
#pragma unroll
    for (int a = 0; a < 2; ++a)
#pragma unroll
        for (int b = 0; b < 2; ++b)
#pragma unroll
            for (int m = 0; m < 4; ++m)
#pragma unroll
                for (int n = 0; n < 2; ++n) acc[a][b][m][n] = (f32x4){zf_, zf_, zf_, zf_};
    bf16x8 At[4][2], B0[2][2], B1[2][2];
    const char* cA = (const char*)g.A + (size_t)cur.pm * tstepA; const char* cB = (const char*)g.Bt + (size_t)cur.pn * tstepB;
    S.a_ready(cur);
    if constexpr (SP2) {
        PG8_STAGE(PG8_SB(0, 0), cB, voffB); PG8_STAGE(PG8_SB(0, 1), cB + hstepB, voffB); PG8_STAGE(PG8_SA(0, 0), cA, voffA); PG8_STAGE(PG8_SA(0, 1), cA + hstepA, voffA);
        if (wr == 1) PG8_BAR;
        PG8_WAIT_V(2); PG8_BAR;
        PG8_STAGE(PG8_SB(1, 0), cB + kstep, voffB); PG8_STAGE(PG8_SA(1, 0), cA + kstep, voffA); PG8_STAGE(PG8_SB(1, 1), cB + hstepB + kstep, voffB);
        PG8_WAIT_V(6); PG8_BAR;
    } else {
        PG8_STAGE(PG8_SB(0, 0), cB, voffB); PG8_STAGE(PG8_SA(0, 0), cA, voffA); PG8_STAGE(PG8_SB(0, 1), cB + hstepB, voffB); PG8_STAGE(PG8_SA(0, 1), cA + hstepA, voffA);
        if (wr == 1) PG8_BAR;
        PG8_WAIT_V(4); PG8_BAR;
        PG8_STAGE(PG8_SB(1, 0), cB + kstep, voffB); PG8_STAGE(PG8_SA(1, 0), cA + kstep, voffA); PG8_STAGE(PG8_SB(1, 1), cB + hstepB + kstep, voffB);
        PG8_WAIT_V(6); PG8_BAR;
    }
    for (;;) {
        const bool has_next = S.next(ui + 1, nxt);
        const char* nA = has_next ? (const char*)g.A + (size_t)nxt.pm * tstepA : cA; const char* nB = has_next ? (const char*)g.Bt + (size_t)nxt.pn * tstepB : cB;
        for (int t = 0; t < nt; t += 2) {
            const bool last = (t == nt - 2);
            const char* a1 = cA + (size_t)(t + 1) * kstep;
            const char* a2 = last ? nA : cA + (size_t)(t + 2) * kstep; const char* b2 = last ? nB : cB + (size_t)(t + 2) * kstep;
            const char* a3 = a2 + kstep; const char* b3 = b2 + kstep;
            if (last && has_next) S.a_ready(nxt);
            if constexpr (SP2) {
            PG8_LDB(B0, 0, 0); PG8_LDB(B1, 0, 1); PG8_SCHED; PG8_LDA(At, 0, 0); PG8_STAGE(PG8_SA(1, 1), a1 + hstepA, voffA);
            PG8_WAIT_V(8); PG8_WAIT_L(0); PG8_BAR; PG8_MMA(0, 0, At, B0); PG8_MMA(0, 1, At, B1); PG8_BAR; PG8_SCHED;
            PG8_LDA(At, 0, 1); PG8_STAGE(PG8_SB(0, 0), b2, voffB); PG8_STAGE(PG8_SB(0, 1), b2 + hstepB, voffB); PG8_STAGE(PG8_SA(0, 0), a2, voffA);
            PG8_WAIT_V(8); PG8_WAIT_L(0); PG8_BAR; PG8_MMA(1, 0, At, B0); PG8_MMA(1, 1, At, B1); PG8_BAR; PG8_SCHED;
            PG8_LDB(B0, 1, 0); PG8_LDB(B1, 1, 1); PG8_SCHED; PG8_LDA(At, 1, 0); PG8_STAGE(PG8_SA(0, 1), a2 + hstepA, voffA);
            PG8_WAIT_V(8); PG8_WAIT_L(0); PG8_BAR; PG8_MMA(0, 0, At, B0); PG8_MMA(0, 1, At, B1); PG8_BAR; PG8_SCHED;
            PG8_LDA(At, 1, 1); PG8_STAGE(PG8_SB(1, 0), b3, voffB); PG8_STAGE(PG8_SB(1, 1), b3 + hstepB, voffB); PG8_STAGE(PG8_SA(1, 0), a3, voffA);
            PG8_WAIT_V(8); PG8_WAIT_L(0); PG8_BAR; PG8_MMA(1, 0, At, B0); PG8_MMA(1, 1, At, B1); PG8_BAR; PG8_SCHED;
            } else {
            PG8_LDB(B0, 0, 0); PG8_SCHED; PG8_LDA(At, 0, 0); PG8_STAGE(PG8_SA(1, 1), a1 + hstepA, voffA);
            PG8_WAIT_L(8); PG8_BAR; PG8_WAIT_L(0); PG8_MMA(0, 0, At, B0); PG8_BAR; PG8_SCHED;
            PG8_LDB(B1, 0, 1); PG8_STAGE(PG8_SB(0, 0), b2, voffB);
            PG8_BAR; PG8_WAIT_L(0); PG8_MMA(0, 1, At, B1); PG8_BAR;
            PG8_LDA(At, 0, 1); PG8_STAGE(PG8_SA(0, 0), a2, voffA);
            PG8_BAR; PG8_WAIT_L(0); PG8_MMA(1, 0, At, B0); PG8_BAR; PG8_SCHED;
            PG8_STAGE(PG8_SB(0, 1), b2 + hstepB, voffB);
            PG8_WAIT_V(6); PG8_BAR; PG8_MMA(1, 1, At, B1); PG8_BAR;
            PG8_LDB(B0, 1, 0); PG8_SCHED; PG8_LDA(At, 1, 0); PG8_STAGE(PG8_SA(0, 1), a2 + hstepA, voffA);
            PG8_WAIT_L(8); PG8_BAR; PG8_WAIT_L(0); PG8_MMA(0, 0, At, B0); PG8_BAR; PG8_SCHED;
            PG8_LDB(B1, 1, 1); PG8_STAGE(PG8_SB(1, 0), b3, voffB);
            PG8_BAR; PG8_WAIT_L(0); PG8_MMA(0, 1, At, B1); PG8_BAR;
            PG8_LDA(At, 1, 1); PG8_STAGE(PG8_SA(1, 0), a3, voffA);
            PG8_BAR; PG8_WAIT_L(0); PG8_MMA(1, 0, At, B0); PG8_BAR; PG8_SCHED;
            PG8_STAGE(PG8_SB(1, 1), b3 + hstepB, voffB);
            PG8_WAIT_V(6); PG8_BAR; PG8_MMA(1, 1, At, B1); PG8_BAR;
            }
        }
        if constexpr (ALIGN_EPI) { if (wr == 0) PG8_BAR; }
        if constexpr (!Epi::AFTER_DRAIN) { E(acc, cur, wr, wc, fr, fq); S.done(cur); }
        if (!has_next) break;
#pragma unroll
        for (int a = 0; a < 2; ++a)
#pragma unroll
            for (int b = 0; b < 2; ++b)
#pragma unroll
                for (int m = 0; m < 4; ++m)
#pragma unroll
                    for (int n = 0; n < 2; ++n) acc[a][b][m][n] = (f32x4){zf_, zf_, zf_, zf_};
        cur = nxt; cA = nA; cB = nB; ++ui;
        if constexpr (ALIGN_EPI) { if (wr == 1) PG8_BAR; }
    }
    PG8_WAIT_V(0);
    if constexpr (!ALIGN_EPI) { if (wr == 0) PG8_BAR; }
    PG8_BAR;
    if constexpr (Epi::AFTER_DRAIN) { E.fused(acc, cur, wr, wc, fr, fq, lds, wid, lane); S.done(cur); }
#undef PG8_SA
#undef PG8_SB
#undef PG8_STAGE
#undef PG8_LDA
#undef PG8_LDB
#undef PG8_MMA
#undef PG8_WAIT_V
#undef PG8_WAIT_L
#undef PG8_BAR
#undef PG8_SCHED
}
}

namespace mk {
using pg8::bf16_t; using pg8::bf16x8; using pg8::f32x4; using pg8::u32x4; using pg8::cvt_pk_bf16;
typedef float f32x16 __attribute__((ext_vector_type(16)));
typedef unsigned u32x2 __attribute__((ext_vector_type(2)));
typedef float f32x2v __attribute__((ext_vector_type(2)));
#define LAS __attribute__((address_space(3)))

constexpr int M = 49152, NP = 16384, D = 1024, DEPTH = 4, NWAVES = 8;
constexpr int ZP = 2048;
constexpr float EPS = 1e-6f, LOG2E = 1.4426950408889634f;
constexpr int ZC_AQ = 0, ZC_AKV = 256, ZC_AKR = 384, ZC_BQ = 512, ZC_BK = 768, ZC_BV = 1024, ZC_CQ = 1280, ZC_CK = 1792, ZC_CV = 1920;
constexpr int ZC_QA = 512, ZC_KA = 896, ZC_KRR = 416;
constexpr size_t OFF_WIN = 0, OFF_WUQ = OFF_WIN + 2048 * 1024, OFF_WUKV = OFF_WUQ + 512 * 256, OFF_WOUT = OFF_WUKV + 512 * 128,
                 OFF_WUP = OFF_WOUT + 1024 * 1024, OFF_WDN = OFF_WUP + 5632 * 1024, WL_STRIDE = OFF_WDN + 1024 * 2816;
constexpr size_t MiB = 1u << 20;
constexpr size_t WS_CTL = 0, WS_TAB = 1 * MiB, WS_BIAS = 2 * MiB, WS_W = 3 * MiB, WS_XB = 95 * MiB, WS_Z = 192 * MiB, WS_VA = 384 * MiB,
                 WS_OB = 408 * MiB, WS_LSE = 480 * MiB, WS_END = 483 * MiB;
static_assert(WS_W + 4 * WL_STRIDE * 2 <= WS_XB, "weights");
static_assert(WS_XB + (size_t)(M + 512) * 2048 <= WS_Z, "xb");
constexpr int LDS_BYTES = 147456;
constexpr int NPH = 1 + 9 * DEPTH;
#ifndef REP_BAR
#define REP_BAR 1
#endif
#ifndef REP_PRO
#define REP_PRO 1
#endif
#ifndef REP_ATT
#define REP_ATT 1
#endif
#ifndef REP_DIL
#define REP_DIL 1
#endif
#ifndef REP_GIN
#define REP_GIN 1
#endif
#ifndef REP_GUP
#define REP_GUP 1
#endif
#ifndef REP_GDN
#define REP_GDN 1
#endif

__device__ const float INVF[16] = {1.0f, 0.5623413324356079f, 0.3162277638912201f, 0.17782793939113617f, 0.10000000149011612f, 0.05623413249850273f,
    0.03162277489900589f, 0.017782794311642647f, 0.009999999776482582f, 0.005623413249850273f, 0.003162277629598975f, 0.0017782794311642647f,
    0.0010000000474974513f, 0.000562341301701963f, 0.0003162277571391314f, 0.00017782794020604342f};

struct Args { const float* in[19]; float* out; unsigned char* ws; int ph_lo, ph_hi; };

__device__ __forceinline__ u32x4 zero4() { unsigned z = 0u; asm volatile("" : "+v"(z)); return (u32x4){z, z, z, z}; }
__device__ __forceinline__ float bf2f(unsigned short b) { return __uint_as_float((unsigned)b << 16); }
__device__ __forceinline__ float bflo(unsigned w) { return __uint_as_float(w << 16); }
__device__ __forceinline__ float bfhi(unsigned w) { return __uint_as_float(w & 0xffff0000u); }
#define SHX(v, o) __int_as_float(__builtin_amdgcn_ds_bpermute((lane ^ (o)) << 2, __float_as_int(v)))
#define DPPF(v, ctrl) __int_as_float(__builtin_amdgcn_update_dpp(0, __float_as_int(v), (ctrl), 0xf, 0xf, false))
__device__ __forceinline__ float row16_sum(float v) { v += DPPF(v, 0x128); v += DPPF(v, 0x124); v += DPPF(v, 0x122); v += DPPF(v, 0x121); return v; }
__device__ __forceinline__ float wave_sum(float v, int lane) {
    v = row16_sum(v); v += SHX(v, 16); v += SHX(v, 32);
    return v;
}
__device__ __forceinline__ void tok_info(int T, int& t, int& S) {
    if (T < NP) { S = 8192; t = T & 8191; } else { S = 2048; t = (T - NP) & 2047; }
}

__device__ __forceinline__ void transpose_item(const float* __restrict__ W, int K, int N, const float* __restrict__ gain, bf16_t* WT, int mode, LAS float* scr, int item, int lane) {
    const int nblk = N / 32, kb = item / nblk, nb = item % nblk, k0 = 64 * kb, n0 = 32 * nb;
    float wv[32];
#pragma unroll
    for (int i = 0; i < 32; ++i) wv[i] = W[(size_t)(k0 + 2 * i + (lane >> 5)) * N + n0 + (lane & 31)];
#pragma unroll
    for (int i = 0; i < 32; ++i) { const int kk = 2 * i + (lane >> 5); const float g = gain ? gain[k0 + kk] : 1.0f; scr[kk * 33 + (lane & 31)] = wv[i] * g; }
    asm volatile("s_waitcnt lgkmcnt(0)" ::: "memory");
    int d0 = n0;
    if (mode == 1) d0 = (n0 < 416) ? n0 : n0 + 96;
    else if (mode == 2) { d0 = (n0 < 2816) ? (256 * (n0 / 128) + (n0 % 128)) : (256 * ((n0 - 2816) / 128) + 128 + ((n0 - 2816) % 128)); }
    const int c = lane & 7;
#pragma unroll
    for (int j = 0; j < 4; ++j) { const int n = (lane >> 3) + 8 * j; const LAS float* s = scr + (8 * c) * 33 + n;
        u32x4 o; o.x = cvt_pk_bf16(s[0 * 33], s[1 * 33]); o.y = cvt_pk_bf16(s[2 * 33], s[3 * 33]); o.z = cvt_pk_bf16(s[4 * 33], s[5 * 33]); o.w = cvt_pk_bf16(s[6 * 33], s[7 * 33]);
        *(u32x4*)(WT + (size_t)(d0 + n) * K + k0 + 8 * c) = o; }
    asm volatile("s_waitcnt lgkmcnt(0)" ::: "memory");
}

__device__ __forceinline__ void row_norm_store(const f32x4 (&v)[4], bf16_t* orow, int lane) {
    float s = 0.f;
#pragma unroll
    for (int j = 0; j < 4; ++j) s += (v[j].x * v[j].x + v[j].y * v[j].y) + (v[j].z * v[j].z + v[j].w * v[j].w);
    const float r = __builtin_amdgcn_rsqf(wave_sum(s, lane) * (1.0f / D) + EPS);
    u32x2* o8 = (u32x2*)orow + lane;
#pragma unroll
    for (int j = 0; j < 4; ++j) { u32x2 w; w.x = cvt_pk_bf16(v[j].x * r, v[j].y * r); w.y = cvt_pk_bf16(v[j].z * r, v[j].w * r); o8[64 * j] = w; }
}

__device__ __forceinline__ void phase_prologue(const Args& a, LAS unsigned char* lds, int G, int bid, int tid, int wid, int lane) {
    unsigned char* ws = a.ws;
    bf16_t* Wb = (bf16_t*)(ws + WS_W);
    LAS float* scr = (LAS float*)(lds + wid * 16384);
    const int gw = bid * NWAVES + wid, NGW = G * NWAVES;
    const int gt = bid * 512 + tid, NGT = G * 512;
    if (gt < 256) ((unsigned*)(ws + WS_CTL))[gt] = 0u;
    for (int i = gt; i < 3456; i += NGT) ((unsigned*)(ws + WS_CTL + 65536))[i] = 0u;
    if (gt < 19) ((const float**)(ws + WS_CTL + 1024))[gt] = a.in[gt];
    constexpr int C_IN = 16 * 61, C_UQ = 4 * 12, C_UKV = 2 * 16, C_OUT = 16 * 32, C_UP = 16 * 176, C_DN = 44 * 32, C_ALL = C_IN + C_UQ + C_UKV + C_OUT + C_UP + C_DN;
    for (int it = gw; it < DEPTH * C_ALL; it += NGW) {
        const int l = it / C_ALL; int r = it % C_ALL; bf16_t* Wl = Wb + (size_t)l * WL_STRIDE;
        if (r < C_IN) { transpose_item(a.in[5] + (size_t)l * 1024 * 1952, 1024, 1952, a.in[3] + l * 1024, Wl + OFF_WIN, 1, scr, r, lane); continue; } r -= C_IN;
        if (r < C_UQ) { transpose_item(a.in[7] + (size_t)l * 256 * 384, 256, 384, a.in[6] + l * 256, Wl + OFF_WUQ, 0, scr, r, lane); continue; } r -= C_UQ;
        if (r < C_UKV) { transpose_item(a.in[9] + (size_t)l * 128 * 512, 128, 512, a.in[8] + l * 128, Wl + OFF_WUKV, 0, scr, r, lane); continue; } r -= C_UKV;
        if (r < C_OUT) { transpose_item(a.in[12] + (size_t)l * 1024 * 1024, 1024, 1024, nullptr, Wl + OFF_WOUT, 0, scr, r, lane); continue; } r -= C_OUT;
        if (r < C_UP) { transpose_item(a.in[15] + (size_t)l * 1024 * 5632, 1024, 5632, a.in[13] + l * 1024, Wl + OFF_WUP, 2, scr, r, lane); continue; } r -= C_UP;
        transpose_item(a.in[18] + (size_t)l * 2816 * 1024, 2816, 1024, nullptr, Wl + OFF_WDN, 0, scr, r, lane);
    }
    constexpr int ZP_IN = 96 * 1024 / 8, ZP_UQ = 128 * 256 / 8;
    for (int i = gt; i < DEPTH * (ZP_IN + ZP_UQ); i += NGT) {
        const int l = i / (ZP_IN + ZP_UQ), r = i % (ZP_IN + ZP_UQ); bf16_t* Wl = Wb + (size_t)l * WL_STRIDE;
        bf16_t* p = (r < ZP_IN) ? (Wl + OFF_WIN + (size_t)416 * 1024 + (size_t)r * 8) : (Wl + OFF_WUQ + (size_t)384 * 256 + (size_t)(r - ZP_IN) * 8);
        *(u32x4*)p = zero4();
    }
    { bf16_t* xb0 = (bf16_t*)(ws + WS_XB);
      for (int i = gt; i < 2 * 256 * 1024 / 8; i += NGT) { const int half = i / (256 * 1024 / 8), r = i % (256 * 1024 / 8);
          *(u32x4*)(xb0 + (size_t)half * (size_t)(M + 256) * 1024 + (size_t)r * 8) = zero4(); } }
    { f32x2v* tab = (f32x2v*)(ws + WS_TAB);
      for (int i = gt; i < 8192 * 16; i += NGT) { const int p = i >> 4, j = i & 15; const float ang = (float)p * INVF[j];
          double rev = (double)ang * 0.15915494309189535; rev -= __builtin_rint(rev); const float f = (float)rev;
          tab[i] = (f32x2v){__builtin_amdgcn_cosf(f), __builtin_amdgcn_sinf(f)}; } }
    { float* bt = (float*)(ws + WS_BIAS); const float* rb = a.in[2];
      for (int i = gt; i < 3 * 129 * 4; i += NGT) { const int p = i / 516, jj = (i % 516) / 4 - 64, h = i & 3; const int dl = (p == 0) ? 1 : (p == 1 ? 4 : 16);
          const int rel = jj * dl, n = rel < 0 ? -rel : rel; int b;
          if (n < 8) b = n; else b = 8 + (n >= 15) + (n >= 27) + (n >= 50) + (n >= 91) + (n >= 166) + (n >= 305) + (n >= 559);
          if (rel > 0) b += 16;
          bt[i] = rb[b * 4 + h] * LOG2E; } }
    { bf16_t* XBp = (bf16_t*)(ws + WS_XB) + (size_t)256 * 1024; const int sub = lane & 15, rsel = lane >> 4;
      for (int m0 = gw * 4; m0 < M; m0 += NGW * 4) { const int m = m0 + rsel;
          const float* src = (m < NP) ? (a.in[0] + (size_t)m * D) : (a.in[1] + (size_t)(m - NP) * D);
          const f32x4* xr = (const f32x4*)src + sub; f32x4* xo = (f32x4*)(a.out + (size_t)m * D) + sub; f32x4 v[16]; float s2 = 0.f;
#pragma unroll
          for (int j = 0; j < 16; ++j) v[j] = xr[16 * j];
#pragma unroll
          for (int j = 0; j < 16; ++j) { xo[16 * j] = v[j]; s2 += (v[j].x * v[j].x + v[j].y * v[j].y) + (v[j].z * v[j].z + v[j].w * v[j].w); }
          const float r2 = __builtin_amdgcn_rsqf(row16_sum(s2) * (1.0f / D) + EPS);
          u32x2* o8 = (u32x2*)(XBp + (size_t)m * D) + sub;
#pragma unroll
          for (int j = 0; j < 16; ++j) { u32x2 w; w.x = cvt_pk_bf16(v[j].x * r2, v[j].y * r2); w.y = cvt_pk_bf16(v[j].z * r2, v[j].w * r2); o8[16 * j] = w; } } }
}

template <bool WRITE_XB = true>
__device__ __forceinline__ void phase_resnorm(const bf16_t* Y, const float* gpost, float* X, bf16_t* XB, int G, int bid, int wid, int lane) {
    const int gw = bid * NWAVES + wid, NGW = G * NWAVES, sub = lane & 15, rsel = lane >> 4;
    for (int m0 = gw * 4; m0 < M; m0 += NGW * 4) {
        const int m = m0 + rsel;
        const u32x2* yr = (const u32x2*)(Y + (size_t)m * D) + sub; f32x4* xr = (f32x4*)(X + (size_t)m * D) + sub;
        u32x2 yw[16]; f32x4 x[16];
#pragma unroll
        for (int j = 0; j < 16; ++j) { yw[j] = yr[16 * j]; x[j] = __builtin_nontemporal_load(&xr[16 * j]); }
        float s = 0.f;
#pragma unroll
        for (int j = 0; j < 16; ++j) { const float a0 = bflo(yw[j].x), a1 = bfhi(yw[j].x), a2 = bflo(yw[j].y), a3 = bfhi(yw[j].y); s += (a0 * a0 + a1 * a1) + (a2 * a2 + a3 * a3); }
        const float r = __builtin_amdgcn_rsqf(row16_sum(s) * (1.0f / D) + EPS);
        float s2 = 0.f;
#pragma unroll
        for (int j = 0; j < 16; ++j) { const f32x4 gp = ((const f32x4*)gpost)[sub + 16 * j]; const f32x4 y = (f32x4){bflo(yw[j].x), bfhi(yw[j].x), bflo(yw[j].y), bfhi(yw[j].y)};
            x[j] = x[j] + y * r * gp; __builtin_nontemporal_store(x[j], &xr[16 * j]); s2 += (x[j].x * x[j].x + x[j].y * x[j].y) + (x[j].z * x[j].z + x[j].w * x[j].w); }
        if (!WRITE_XB) continue;
        const float r2 = __builtin_amdgcn_rsqf(row16_sum(s2) * (1.0f / D) + EPS);
        u32x2* o8 = (u32x2*)(XB + (size_t)m * D) + sub;
#pragma unroll
        for (int j = 0; j < 16; ++j) { u32x2 w; w.x = cvt_pk_bf16(x[j].x * r2, x[j].y * r2); w.y = cvt_pk_bf16(x[j].z * r2, x[j].w * r2); o8[16 * j] = w; }
    }
}

struct TokRegs { u32x2 aq; unsigned akv; float kr; u32x4 cq, ck; f32x2v cskr; f32x2v cs[8]; int t; };
__device__ __forceinline__ void token_load(TokRegs& R, const bf16_t* Z, const f32x2v* tab, int T, int lane) {
    const bf16_t* z = Z + (size_t)T * ZP; int S; tok_info(T, R.t, S);
    R.aq = *((const u32x2*)(z + ZC_AQ) + lane); R.akv = *((const unsigned*)(z + ZC_AKV) + lane); R.kr = bf2f(z[ZC_AKR + (lane & 31)]);
    R.cq = *(const u32x4*)(z + ZC_CQ + 8 * lane); R.ck = *(const u32x4*)(z + ZC_CK + 8 * (lane & 15));
    R.cskr = tab[R.t * 16 + (lane & 15)];
    const int sub = lane & 7, jb = 8 * (sub & 1), pos = (sub < 4) ? (R.t >> 6) : (R.t & 63);
#pragma unroll
    for (int e = 0; e < 8; ++e) R.cs[e] = tab[pos * 16 + jb + e];
}
__device__ __forceinline__ void token_finish(const TokRegs& R, bf16_t* Z, const float* cqn, const float* ckn, int T, int lane) {
    bf16_t* z = Z + (size_t)T * ZP;
    { const float a0 = bflo(R.aq.x), a1 = bfhi(R.aq.x), a2 = bflo(R.aq.y), a3 = bfhi(R.aq.y);
      const float r = __builtin_amdgcn_rsqf(wave_sum((a0 * a0 + a1 * a1) + (a2 * a2 + a3 * a3), lane) * (1.0f / 256.0f) + EPS);
      u32x2 o; o.x = cvt_pk_bf16(a0 * r, a1 * r); o.y = cvt_pk_bf16(a2 * r, a3 * r); *((u32x2*)(z + ZC_AQ) + lane) = o; }
    { const float a0 = bflo(R.akv), a1 = bfhi(R.akv);
      const float r = __builtin_amdgcn_rsqf(wave_sum(a0 * a0 + a1 * a1, lane) * (1.0f / 128.0f) + EPS);
      *((unsigned*)(z + ZC_AKV) + lane) = cvt_pk_bf16(a0 * r, a1 * r); }
    { const float v = R.kr; const float pv = SHX(v, 16);
      const float o = (lane & 16) ? (v * R.cskr.x + pv * R.cskr.y) : (v * R.cskr.x - pv * R.cskr.y);
      const unsigned short ob = (unsigned short)(cvt_pk_bf16(o, 0.f) & 0xffffu);
      if (lane < 32) z[ZC_KRR + lane] = ob; }
    const int sub = lane & 7; const bool isx2 = (sub >> 1) & 1;
#pragma unroll
    for (int pass = 0; pass < 2; ++pass) {
        const bool act = (pass == 0) || (lane < 16);
        bf16_t* p = z + (pass == 0 ? ZC_CQ + 8 * lane : ZC_CK + 8 * (lane & 15));
        const float* gn = (pass == 0 ? cqn : ckn) + 8 * sub;
        const u32x4 w = (pass == 0) ? R.cq : R.ck; float v[8] = {bflo(w.x), bfhi(w.x), bflo(w.y), bfhi(w.y), bflo(w.z), bfhi(w.z), bflo(w.w), bfhi(w.w)};
        float s = 0.f;
#pragma unroll
        for (int e = 0; e < 8; ++e) s += v[e] * v[e];
        s += DPPF(s, 0xB1); s += DPPF(s, 0x4E); s += SHX(s, 4);
        const float r = __builtin_amdgcn_rsqf(s * (1.0f / 64.0f) + EPS);
        const float sc = (pass == 0) ? (0.125f * LOG2E) : 1.0f;
        float o[8];
#pragma unroll
        for (int e = 0; e < 8; ++e) { v[e] = v[e] * r * gn[e]; }
#pragma unroll
        for (int e = 0; e < 8; ++e) { const float pv = DPPF(v[e], 0x4E); o[e] = (isx2 ? (v[e] * R.cs[e].x + pv * R.cs[e].y) : (v[e] * R.cs[e].x - pv * R.cs[e].y)) * sc; }
        u32x4 ow; ow.x = cvt_pk_bf16(o[0], o[1]); ow.y = cvt_pk_bf16(o[2], o[3]); ow.z = cvt_pk_bf16(o[4], o[5]); ow.w = cvt_pk_bf16(o[6], o[7]);
        if (act) *(u32x4*)p = ow;
    }
}

#define MFMA32(a, b, c) __builtin_amdgcn_mfma_f32_32x32x16_bf16((a), (b), (c), 0, 0, 0)
__device__ __forceinline__ bf16x8 pack8(const float* p) { u32x4 w; w.x = cvt_pk_bf16(p[0], p[1]); w.y = cvt_pk_bf16(p[2], p[3]); w.z = cvt_pk_bf16(p[4], p[5]); w.w = cvt_pk_bf16(p[6], p[7]); return __builtin_bit_cast(bf16x8, w); }

__device__ __forceinline__ void dil_item(LAS unsigned char* lds, int item, const bf16_t* Z, bf16_t* OB, float* LSE, const float* biasT, int tid, int wid, int lane) {
    constexpr int KP = 72, KB = 64 * KP * 2, PAIRB = 2 * KB + 528;
    const int g = wid >> 1, hf = wid & 1, pt = tid & 127, q = lane & 31, hi = lane >> 5;
    const int rho_pi = (q & ~12) | ((q & 4) << 1) | ((q & 8) >> 1);
    const int nb = item * 4 + g, p = nb / 3072, rem = nb % 3072, h = rem / 768, blk = rem % 768;
    const int dl = (p == 0) ? 1 : (p == 1 ? 4 : 16);
    int S, sbase, k, bpr;
    if (blk < 256) { S = 8192; sbase = (blk >> 7) * 8192; k = blk & 127; bpr = 128 / dl; }
    else { const int b2 = blk - 256; S = 2048; sbase = NP + (b2 >> 5) * 2048; k = b2 & 31; bpr = 32 / dl; }
    const int r = k / bpr, n = k % bpr, L = 64 * bpr;
    LAS unsigned char* Kl = lds + g * PAIRB; LAS unsigned char* Vl = Kl + KB; LAS float* bl = (LAS float*)(Kl + 2 * KB);
    bl[pt] = biasT[(p * 129 + pt) * 4 + h]; if (pt == 0) bl[128] = biasT[(p * 129 + 128) * 4 + h];
    const int qi = 32 * hf + q; const int tq = sbase + (64 * n + qi) * dl + r;
    bf16x8 qf[4];
#pragma unroll
    for (int ks = 0; ks < 4; ++ks) qf[ks] = *(const bf16x8*)(Z + (size_t)tq * ZP + ZC_BQ + h * 64 + 16 * ks + 8 * hi);
    f32x16 oacc[2]; float zf_ = 0.f; asm volatile("" : "+v"(zf_));
#pragma unroll
    for (int i = 0; i < 16; ++i) { oacc[0][i] = zf_; oacc[1][i] = zf_; }
    float m_run = -INFINITY, l_run = 0.f;
    u32x4 kst[4], vst[2][2];
#define DIL_GLOAD(ktv) do { const int l0_ = 64 * (n + (ktv)); \
        _Pragma("unroll") for (int i_ = 0; i_ < 4; ++i_) { const int c_ = pt + 128 * i_, row_ = c_ >> 3, ch_ = c_ & 7, lk_ = l0_ + row_; kst[i_] = zero4(); \
            if (lk_ >= 0 && lk_ < L) kst[i_] = *(const u32x4*)(Z + (size_t)(sbase + lk_ * dl + r) * ZP + ZC_BK + h * 64 + 8 * ch_); } \
        _Pragma("unroll") for (int i_ = 0; i_ < 2; ++i_) { const int dch_ = (pt >> 5) + 4 * i_, kp2_ = pt & 31, lk_ = l0_ + 2 * kp2_; vst[i_][0] = zero4(); vst[i_][1] = zero4(); \
            if (lk_ >= 0 && lk_ < L) vst[i_][0] = *(const u32x4*)(Z + (size_t)(sbase + lk_ * dl + r) * ZP + ZC_BV + h * 64 + 8 * dch_); \
            if (lk_ + 1 >= 0 && lk_ + 1 < L) vst[i_][1] = *(const u32x4*)(Z + (size_t)(sbase + (lk_ + 1) * dl + r) * ZP + ZC_BV + h * 64 + 8 * dch_); } } while (0)
    DIL_GLOAD(0);
#pragma unroll 1
    for (int kti = 0; kti < 3; ++kti) {
        const int kt = (kti == 0) ? 0 : (kti == 1 ? -1 : 1); const int l0 = 64 * (n + kt);
#pragma unroll
        for (int i = 0; i < 4; ++i) { const int c = pt + 128 * i, row = c >> 3, ch = c & 7; *(LAS u32x4*)(Kl + (row * KP + 8 * ch) * 2) = kst[i]; }
#pragma unroll
        for (int i = 0; i < 2; ++i) { const int dch = (pt >> 5) + 4 * i, kp2 = pt & 31; LAS unsigned* vt = (LAS unsigned*)Vl;
#pragma unroll
            for (int e = 0; e < 8; ++e) { const unsigned a = vst[i][0][e >> 1], b = vst[i][1][e >> 1]; const unsigned w = (e & 1) ? ((a >> 16) | (b & 0xffff0000u)) : ((a & 0xffffu) | (b << 16));
                vt[(8 * dch + e) * (KP / 2) + kp2] = w; } }
        __syncthreads();
        if (kti == 0) DIL_GLOAD(-1); else if (kti == 1) DIL_GLOAD(1);
        f32x16 sacc[2];
#pragma unroll
        for (int kb = 0; kb < 2; ++kb) {
#pragma unroll
            for (int i = 0; i < 16; ++i) sacc[kb][i] = zf_;
#pragma unroll
            for (int ks = 0; ks < 4; ++ks) { const bf16x8 kf = *(const LAS bf16x8*)(Kl + ((32 * kb + rho_pi) * KP + 16 * ks + 8 * hi) * 2); sacc[kb] = MFMA32(kf, qf[ks], sacc[kb]); } }
        float mx = -INFINITY;
#pragma unroll
        for (int kb = 0; kb < 2; ++kb)
#pragma unroll
            for (int i = 0; i < 16; ++i) { const int kk = 32 * kb + 16 * (i >> 3) + 8 * hi + (i & 7); const int rel = 64 * kt + kk - qi, lk = l0 + kk;
                const bool ok = (rel >= -64) && (rel <= 64) && (lk >= 0) && (lk < L); const int bi = ok ? (rel + 64) : 64;
                const float s = ok ? (sacc[kb][i] * (0.125f * LOG2E) + bl[bi]) : -INFINITY; sacc[kb][i] = s; mx = fmaxf(mx, s); }
        mx = fmaxf(mx, SHX(mx, 32));
        const float m_new = fmaxf(m_run, mx), alpha = __builtin_amdgcn_exp2f(m_run - m_new); m_run = m_new;
        float ls = 0.f; float pr[2][16];
#pragma unroll
        for (int kb = 0; kb < 2; ++kb)
#pragma unroll
            for (int i = 0; i < 16; ++i) { const float e = __builtin_amdgcn_exp2f(sacc[kb][i] - m_new); pr[kb][i] = e; ls += e; }
        l_run = l_run * alpha + ls;
#pragma unroll
        for (int i = 0; i < 16; ++i) { oacc[0][i] *= alpha; oacc[1][i] *= alpha; }
#pragma unroll
        for (int kb = 0; kb < 2; ++kb)
#pragma unroll
            for (int s2 = 0; s2 < 2; ++s2) { const bf16x8 pf = pack8(&pr[kb][8 * s2]);
#pragma unroll
                for (int db = 0; db < 2; ++db) { const bf16x8 vf = *(const LAS bf16x8*)(Vl + ((32 * db + q) * KP + 32 * kb + 16 * s2 + 8 * hi) * 2); oacc[db] = MFMA32(vf, pf, oacc[db]); } }
        __syncthreads();
    }
#undef DIL_GLOAD
    const float lt = l_run + SHX(l_run, 32), inv = 1.0f / lt;
    bf16_t* orow = OB + ((size_t)p * M + tq) * 256 + h * 64;
#pragma unroll
    for (int db = 0; db < 2; ++db)
#pragma unroll
        for (int g4 = 0; g4 < 4; ++g4) { u32x2 w; w.x = cvt_pk_bf16(oacc[db][4 * g4] * inv, oacc[db][4 * g4 + 1] * inv); w.y = cvt_pk_bf16(oacc[db][4 * g4 + 2] * inv, oacc[db][4 * g4 + 3] * inv);
            *(u32x2*)(orow + 32 * db + 8 * g4 + 4 * hi) = w; }
    if (hi == 0) LSE[((size_t)p * M + tq) * 4 + h] = m_run + __builtin_amdgcn_logf(lt);
}

template <int DQK>
__device__ __forceinline__ void dense_item(LAS unsigned char* lds, const bf16_t* Q, int qp, const bf16_t* Kg, const bf16_t* Kg2, int kpitch, const bf16_t* Vg, int vp, bf16_t* O, int op, int nkeys,
                                           int tid, int wid, int lane) {
    constexpr int KP = DQK + 8, VP = 72, KBYTES = 64 * KP * 2, VBYTES = 64 * VP * 2, STAGE = KBYTES + VBYTES, NKS = DQK / 16, CH = DQK / 8, NKL = CH * 64 / 256;
    const int q = lane & 31, hi = lane >> 5;
    typedef __attribute__((address_space(1))) const bf16_t gbf;
    gbf* Kg_ = (gbf*)Kg; gbf* Kg2_ = (gbf*)Kg2; gbf* Vg_ = (gbf*)Vg; gbf* Q_ = (gbf*)Q;
    const int rho_pi = (q & ~12) | ((q & 4) << 1) | ((q & 8) >> 1);
    bf16x8 qf[NKS];
    { gbf* qrow = Q_ + (size_t)(wid * 32 + q) * qp + 8 * hi;
#pragma unroll
      for (int ks = 0; ks < NKS; ++ks) qf[ks] = *(const __attribute__((address_space(1))) bf16x8*)(qrow + 16 * ks); }
    f32x16 oacc[2]; float zf_ = 0.f; asm volatile("" : "+v"(zf_));
#pragma unroll
    for (int i = 0; i < 16; ++i) { oacc[0][i] = zf_; oacc[1][i] = zf_; }
    float m_run = -INFINITY, l_run = 0.f;
    u32x4 st[3];
    const int kp2 = tid & 31, dch = (tid >> 5) & 7, t2 = tid & 255;
#define DA_GLOAD(j) do { const int key0 = (j) * 64; \
        if (wid < 4) { gbf* vsrc = Vg_ + (size_t)(key0 + 2 * kp2) * vp + 8 * dch; st[0] = *(const __attribute__((address_space(1))) u32x4*)vsrc; st[1] = *(const __attribute__((address_space(1))) u32x4*)(vsrc + vp); } \
        else { _Pragma("unroll") for (int i_ = 0; i_ < NKL; ++i_) { const int c_ = t2 + 256 * i_, row_ = c_ / CH, ch_ = c_ % CH; st[i_] = *(const __attribute__((address_space(1))) u32x4*)((ch_ < 8 ? Kg_ + 8 * ch_ : Kg2_ + 8 * (ch_ - 8)) + (size_t)(key0 + row_) * kpitch); } } } while (0)
#define DA_LSTORE(s) do { LAS unsigned char* base_ = lds + (s) * STAGE; \
        if (wid < 4) { LAS unsigned* vt_ = (LAS unsigned*)(base_ + KBYTES); \
            _Pragma("unroll") for (int e_ = 0; e_ < 8; ++e_) { const unsigned a_ = st[0][e_ >> 1], b_ = st[1][e_ >> 1]; \
                const unsigned w_ = (e_ & 1) ? ((a_ >> 16) | (b_ & 0xffff0000u)) : ((a_ & 0xffffu) | (b_ << 16)); vt_[(8 * dch + e_) * (VP / 2) + kp2] = w_; } } \
        else { _Pragma("unroll") for (int i_ = 0; i_ < NKL; ++i_) { const int c_ = t2 + 256 * i_, row_ = c_ / CH, ch_ = c_ % CH; *(LAS u32x4*)(base_ + (row_ * KP + 8 * ch_) * 2) = st[i_]; } } } while (0)
    const int nt = nkeys / 64;
    f32x16 negm;
#pragma unroll
    for (int i = 0; i < 16; ++i) negm[i] = zf_;
#define DA_TILE(j, FIRST) do { \
        if ((j) + 1 < nt) DA_GLOAD((j) + 1); \
        LAS unsigned char* Kl = lds + ((j) & 1) * STAGE; LAS unsigned char* Vl = Kl + KBYTES; \
        f32x16 sacc[2]; bf16x8 kf[2][NKS]; \
        _Pragma("unroll") for (int kb = 0; kb < 2; ++kb) _Pragma("unroll") for (int ks = 0; ks < NKS; ++ks) kf[kb][ks] = *(const LAS bf16x8*)(Kl + ((32 * kb + rho_pi) * KP + 16 * ks + 8 * hi) * 2); \
        __builtin_amdgcn_sched_barrier(0); \
        _Pragma("unroll") for (int kb = 0; kb < 2; ++kb) { sacc[kb] = MFMA32(kf[kb][0], qf[0], negm); \
            _Pragma("unroll") for (int ks = 1; ks < NKS; ++ks) sacc[kb] = MFMA32(kf[kb][ks], qf[ks], sacc[kb]); } \
        bf16x8 vf[2][2][2]; \
        _Pragma("unroll") for (int kb = 0; kb < 2; ++kb) _Pragma("unroll") for (int s2 = 0; s2 < 2; ++s2) _Pragma("unroll") for (int db = 0; db < 2; ++db) \
            vf[kb][s2][db] = *(const LAS bf16x8*)(Vl + ((32 * db + q) * VP + 32 * kb + 16 * s2 + 8 * hi) * 2); \
        __builtin_amdgcn_sched_barrier(0); \
        float ls = 0.f; float pr[2][16]; \
        if (FIRST) { float mx = sacc[0][0]; \
            _Pragma("unroll") for (int i = 0; i < 16; ++i) { mx = fmaxf(mx, sacc[0][i]); mx = fmaxf(mx, sacc[1][i]); } \
            m_run = fmaxf(mx, SHX(mx, 32)); \
            _Pragma("unroll") for (int i = 0; i < 16; ++i) negm[i] = -m_run; \
            _Pragma("unroll") for (int kb = 0; kb < 2; ++kb) _Pragma("unroll") for (int i = 0; i < 16; ++i) { const float e = __builtin_amdgcn_exp2f(sacc[kb][i] - m_run); pr[kb][i] = e; ls += e; } \
        } else { \
            _Pragma("unroll") for (int kb = 0; kb < 2; ++kb) _Pragma("unroll") for (int i = 0; i < 16; ++i) { const float e = __builtin_amdgcn_exp2f(sacc[kb][i]); pr[kb][i] = e; ls += e; } \
            if (__builtin_amdgcn_ballot_w64(ls > 65536.0f) != 0ull) { \
                float d = (ls > 65536.0f) ? __builtin_amdgcn_logf(ls) : 0.f; d = fmaxf(d, SHX(d, 32)); \
                const float al = __builtin_amdgcn_exp2f(-d); m_run += d; ls *= al; l_run *= al; \
                _Pragma("unroll") for (int i = 0; i < 16; ++i) { pr[0][i] *= al; pr[1][i] *= al; oacc[0][i] *= al; oacc[1][i] *= al; negm[i] = -m_run; } \
            } \
        } \
        l_run += ls; \
        _Pragma("unroll") for (int kb = 0; kb < 2; ++kb) _Pragma("unroll") for (int s2 = 0; s2 < 2; ++s2) { const bf16x8 pf = pack8(&pr[kb][8 * s2]); \
            _Pragma("unroll") for (int db = 0; db < 2; ++db) oacc[db] = MFMA32(vf[kb][s2][db], pf, oacc[db]); } \
        if ((j) + 1 < nt) DA_LSTORE(((j) + 1) & 1); \
        __syncthreads(); } while (0)
    DA_GLOAD(0); DA_LSTORE(0);
    __syncthreads();
    DA_TILE(0, true);
    for (int j = 1; j < nt; ++j) DA_TILE(j, false);
#undef DA_TILE
#undef DA_GLOAD
#undef DA_LSTORE
    const float inv = 1.0f / (l_run + SHX(l_run, 32));
    bf16_t* orow = O + (size_t)(wid * 32 + q) * op;
#pragma unroll
    for (int db = 0; db < 2; ++db)
#pragma unroll
        for (int g4 = 0; g4 < 4; ++g4) { u32x2 w; w.x = cvt_pk_bf16(oacc[db][4 * g4] * inv, oacc[db][4 * g4 + 1] * inv); w.y = cvt_pk_bf16(oacc[db][4 * g4 + 2] * inv, oacc[db][4 * g4 + 3] * inv);
            *(u32x2*)(orow + 32 * db + 8 * g4 + 4 * hi) = w; }
}

struct EpiUq {
    static constexpr bool PERM = false, AFTER_DRAIN = false;
    bf16_t* Z; const f32x2v* tab;
    __device__ __forceinline__ void operator()(const f32x4 (&acc)[2][2][4][2], const pg8::Unit& u, int wr_, int wc_, int fr_, int fq_) const {
        int wr = wr_, wc = wc_; unsigned ones_ = ~0u; asm volatile("" : "+s"(wr), "+s"(wc), "+s"(ones_)); int ln_ = __builtin_amdgcn_mbcnt_hi(ones_, __builtin_amdgcn_mbcnt_lo(ones_, 0u)); int fr = ln_ & 15, fq = ln_ >> 4; (void)fr_; (void)fq_;
        const float qs = 0.10206207261596577f * LOG2E;
#pragma unroll
        for (int bj = 0; bj < 2; ++bj) {
            const int gidx = 8 * u.pn + 4 * bj + wc; if (gidx >= 12) continue;
            const bool rope = (gidx % 3) == 2; const int col = ZC_QA + 32 * gidx + 4 * fq;
#pragma unroll
            for (int ai = 0; ai < 2; ++ai)
#pragma unroll
                for (int m = 0; m < 4; ++m) { int frm = fr; asm volatile("" : "+v"(frm)); const int T = u.pm * 256 + ai * 128 + wr * 64 + m * 16 + frm; bf16_t* zr = Z + (size_t)T * ZP + col;
                    f32x4 x1 = acc[ai][bj][m][0], x2 = acc[ai][bj][m][1];
                    if (rope) { int t, S; tok_info(T, t, S); const f32x2v* cs = tab + t * 16 + 4 * fq; f32x4 o1, o2;
#pragma unroll
                        for (int e = 0; e < 4; ++e) { const f32x2v c = cs[e]; o1[e] = x1[e] * c.x - x2[e] * c.y; o2[e] = x2[e] * c.x + x1[e] * c.y; }
                        x1 = o1; x2 = o2; }
                    x1 = x1 * qs; x2 = x2 * qs;
                    u32x2 w; w.x = cvt_pk_bf16(x1[0], x1[1]); w.y = cvt_pk_bf16(x1[2], x1[3]); *(u32x2*)zr = w;
                    w.x = cvt_pk_bf16(x2[0], x2[1]); w.y = cvt_pk_bf16(x2[2], x2[3]); *(u32x2*)(zr + 16) = w; asm volatile("" : "+v"(fr) : "v"(w.x), "v"(w.y) : "memory"); }
        }
    }
};
struct EpiUkv {
    static constexpr bool PERM = false, AFTER_DRAIN = false;
    bf16_t* Z; bf16_t* VA;
    __device__ __forceinline__ void operator()(const f32x4 (&acc)[2][2][4][2], const pg8::Unit& u, int wr_, int wc_, int fr_, int fq_) const {
        int wr = wr_, wc = wc_; unsigned ones_ = ~0u; asm volatile("" : "+s"(wr), "+s"(wc), "+s"(ones_)); int ln_ = __builtin_amdgcn_mbcnt_hi(ones_, __builtin_amdgcn_mbcnt_lo(ones_, 0u)); int fr = ln_ & 15, fq = ln_ >> 4; (void)fr_; (void)fq_;
#pragma unroll
        for (int bj = 0; bj < 2; ++bj) { const int head = 2 * u.pn + bj;
#pragma unroll
            for (int ai = 0; ai < 2; ++ai)
#pragma unroll
                for (int m = 0; m < 4; ++m) { const int T = u.pm * 256 + ai * 128 + wr * 64 + m * 16 + fr;
                    bf16_t* dst = (wc < 2) ? (Z + (size_t)T * ZP + ZC_KA + head * 96 + 32 * wc + 4 * fq) : (VA + (size_t)T * 256 + head * 64 + 32 * (wc - 2) + 4 * fq);
#pragma unroll
                    for (int n = 0; n < 2; ++n) { const f32x4 x = acc[ai][bj][m][n]; u32x2 w; w.x = cvt_pk_bf16(x[0], x[1]); w.y = cvt_pk_bf16(x[2], x[3]); *(u32x2*)(dst + 16 * n) = w; } } }
    }
};
struct EpiUp {
    static constexpr bool PERM = false, AFTER_DRAIN = false;
    bf16_t* Gout; const float* cw; const float* cb;
    __device__ __forceinline__ void operator()(const f32x4 (&acc)[2][2][4][2], const pg8::Unit& u, int wr_, int wc_, int fr_, int fq_) const {
        int wr = wr_, wc = wc_; unsigned ones_ = ~0u; asm volatile("" : "+s"(wr), "+s"(wc), "+s"(ones_)); int ln_ = __builtin_amdgcn_mbcnt_hi(ones_, __builtin_amdgcn_mbcnt_lo(ones_, 0u)); int fr = ln_ & 15, fq = ln_ >> 4; (void)fr_; (void)fq_;
#pragma unroll
        for (int n = 0; n < 2; ++n) {
            int frm = fr; asm volatile("" : "+v"(frm));
            const int jc = 128 * u.pn + 32 * wc + 16 * n + 4 * fq;
            const int Tb = 252 * u.pm + 126 * wr - 1 + frm;
            float mu[8], md[8];
#pragma unroll
            for (int mm = 0; mm < 8; ++mm) { const int T = Tb + 16 * mm; int t, S; tok_info(T < 0 ? 0 : (T >= M ? M - 1 : T), t, S); mu[mm] = (t == 0) ? 0.f : 1.f; md[mm] = (t == S - 1) ? 0.f : 1.f; }
            float gl[8][4];
#pragma unroll
            for (int bj = 0; bj < 2; ++bj) {
                const int c = jc + 2816 * bj;
                const f32x4 w0 = *(const f32x4*)(cw + c), w1 = *(const f32x4*)(cw + 5632 + c), w2 = *(const f32x4*)(cw + 2 * 5632 + c), bb = *(const f32x4*)(cb + c);
#pragma unroll
                for (int e = 0; e < 4; ++e) {
                    float ru[8], rd[8], xv[8];
#pragma unroll
                    for (int mm = 0; mm < 8; ++mm) xv[mm] = acc[mm >> 2][bj][mm & 3][n][e];
                    asm volatile("" : "+v"(xv[0]), "+v"(xv[1]), "+v"(xv[2]), "+v"(xv[3]), "+v"(xv[4]), "+v"(xv[5]), "+v"(xv[6]), "+v"(xv[7]), "+v"(frm));
#pragma unroll
                    for (int mm = 0; mm < 8; ++mm) { ru[mm] = DPPF(xv[mm], 0x121); rd[mm] = DPPF(xv[mm], 0x12F); }
#pragma unroll
                    for (int mm = 0; mm < 8; ++mm) {
                        const float up = (frm == 0) ? ru[mm > 0 ? mm - 1 : 0] : ru[mm];
                        const float dn = (frm == 15) ? rd[mm < 7 ? mm + 1 : 7] : rd[mm];
                        const float cv = bb[e] + w1[e] * xv[mm] + (w0[e] * up) * mu[mm] + (w2[e] * dn) * md[mm];
                        if (bj == 0) { const float ea = cv * (-2.302208198f + -0.102943240f * (cv * cv));
                            gl[mm][e] = cv * __builtin_amdgcn_rcpf(1.0f + __builtin_amdgcn_exp2f(ea)); }
                        else gl[mm][e] = gl[mm][e] * cv;
                    }
                    asm volatile("" : "+v"(frm) : "v"(gl[0][e]), "v"(gl[1][e]), "v"(gl[2][e]), "v"(gl[3][e]), "v"(gl[4][e]), "v"(gl[5][e]), "v"(gl[6][e]), "v"(gl[7][e]));
                }
            }
#pragma unroll
            for (int mm = 0; mm < 8; ++mm) { const int lr = 16 * mm + frm, T = Tb + 16 * mm;
                if (lr >= 1 && lr <= 126 && T < M) { u32x2 w; w.x = cvt_pk_bf16(gl[mm][0], gl[mm][1]); w.y = cvt_pk_bf16(gl[mm][2], gl[mm][3]); *(u32x2*)(Gout + (size_t)T * 2816 + jc) = w; } }
            asm volatile("" ::: "memory"); __builtin_amdgcn_sched_barrier(0);
        }
    }
};
}

using namespace mk;
#define XB_TMO      128
#define XB_XCNT(j)  (256  + 64 * (j))
#define XB_XSUB(j)  (1280 + 64 * (j))
#define XB_XGEN(j)  (2304 + 64 * (j))
#define XB_TOP      3328
#define XB_TOPGEN   3392
#define XCD_BAR_WORDS 3456
#define XB_SPIN_CAP (1u << 18)

__device__ __forceinline__ unsigned xb_ld(unsigned* p)              { return __hip_atomic_load(p, __ATOMIC_RELAXED, __HIP_MEMORY_SCOPE_AGENT); }
__device__ __forceinline__ unsigned xb_add(unsigned* p, unsigned v) { return __hip_atomic_fetch_add(p, v, __ATOMIC_RELAXED, __HIP_MEMORY_SCOPE_AGENT); }
__device__ __forceinline__ unsigned xb_xcc_id() { return (unsigned)__builtin_amdgcn_s_getreg((3 << 11) | 20) & 0xFu; }
#define XB_SPIN(cond, bar) do { unsigned _sp = 0; while (cond) { __builtin_amdgcn_s_sleep(1); \
    if ((++_sp & 255u) == 0u) { if (xb_ld(&(bar)[XB_TMO])) break; if (_sp > XB_SPIN_CAP) { atomicAdd(&(bar)[XB_TMO], 1u); break; } } } } while (0)

struct XcdBarrier {
    unsigned* bar; unsigned x;
    volatile LAS unsigned* st;
};

__device__ __forceinline__ XcdBarrier xcd_barrier_post(unsigned* bar, volatile LAS unsigned* st, bool leader) {
    XcdBarrier b; b.bar = bar; b.x = xb_xcc_id(); b.st = st;
    if (leader) (void)xb_add(&bar[XB_XCNT(b.x)], 1u);
    return b;
}
__device__ __forceinline__ void xcd_barrier_complete(unsigned* bar, unsigned x, unsigned& nloc, unsigned& nx) {
    const unsigned G = gridDim.x * gridDim.y * gridDim.z;
    unsigned sum, cnt, mine, sp = 0u;
    for (;;) {
        sum = 0u; cnt = 0u; mine = 0u;
#pragma unroll
        for (unsigned j = 0; j < 16; ++j) { const unsigned c = xb_ld(&bar[XB_XCNT(j)]); sum += c; cnt += (c > 0u) ? 1u : 0u; mine = (j == x) ? c : mine; }
        if (sum == G) break;
        __builtin_amdgcn_s_sleep(1);
        if ((++sp & 255u) == 0u) { if (xb_ld(&bar[XB_TMO])) break; if (sp > XB_SPIN_CAP) { atomicAdd(&bar[XB_TMO], 1u); break; } }
    }
    nloc = mine > 0u ? mine : 1u; nx = cnt > 0u ? cnt : 1u;
}

__device__ __forceinline__ void xcd_barrier(const XcdBarrier& b, bool leader) {
    asm volatile("s_waitcnt vmcnt(0)" ::: "memory");
    __syncthreads();
    if (leader) {
        unsigned* bar = b.bar;
        __builtin_amdgcn_s_waitcnt(0);
        unsigned nloc = b.st[0], nx = b.st[1];
        if (nloc == 0u) { xcd_barrier_complete(bar, b.x, nloc, nx); b.st[0] = nloc; b.st[1] = nx; }
        const unsigned old = xb_add(&bar[XB_XSUB(b.x)], 1u);
        const unsigned gen = old / nloc;
        if (old + 1u == (gen + 1u) * nloc) {
            __builtin_amdgcn_fence(__ATOMIC_RELEASE, "agent");
            asm volatile("s_waitcnt vmcnt(0)" ::: "memory");
            const unsigned og = xb_add(&bar[XB_TOP], 1u);
            const unsigned tg = og / nx;
            if (og + 1u == (tg + 1u) * nx) xb_add(&bar[XB_TOPGEN], 1u);
            else XB_SPIN(xb_ld(&bar[XB_TOPGEN]) == tg, bar);
            __builtin_amdgcn_fence(__ATOMIC_ACQUIRE, "agent");
            xb_add(&bar[XB_XGEN(b.x)], 1u);
            asm volatile("s_waitcnt vmcnt(0)" ::: "memory");
        } else {
            XB_SPIN(xb_ld(&bar[XB_XGEN(b.x)]) == gen, bar);
            __builtin_amdgcn_fence(__ATOMIC_ACQUIRE, "agent");
            asm volatile("s_waitcnt vmcnt(0)" ::: "memory");
        }
    }
    __syncthreads();
}

template <int PH>
__device__ __forceinline__ void run_phase(const Args& a, LAS unsigned char* lds, int wid0, int G0, int bid0) {
    LAS int* sh_item = (LAS int*)(lds + 143360);
        int G = G0, bid = bid0, wid = wid0; asm volatile("" : "+s"(G), "+s"(bid), "+s"(wid));
        const int gw = bid * NWAVES + wid, NGW = G * NWAVES;
#define FRESH_LANE() unsigned ones_ = ~0u; asm volatile("" : "+s"(ones_)); int lane = __builtin_amdgcn_mbcnt_hi(ones_, __builtin_amdgcn_mbcnt_lo(ones_, 0u)); const int tid = wid * 64 + lane; (void)tid
        unsigned char* ws = a.ws; asm volatile("" : "+s"(ws));
#define ctl ((unsigned*)(ws + WS_CTL))
#define PT ((const float* const*)(ws + WS_CTL + 1024))
#define tab ((const f32x2v*)(ws + WS_TAB))
#define biasT ((const float*)(ws + WS_BIAS))
#define Wb ((bf16_t*)(ws + WS_W))
#define XB ((bf16_t*)(ws + WS_XB) + (size_t)256 * 1024)
#define Z ((bf16_t*)(ws + WS_Z))
#define VA ((bf16_t*)(ws + WS_VA))
#define OB ((bf16_t*)(ws + WS_OB))
#define LSE ((float*)(ws + WS_LSE))
#define MIX Z
#define GB Z
#define X (a.out)
        if constexpr (PH == 0) { FRESH_LANE(); for (int rep = 0; rep < REP_PRO; ++rep) phase_prologue(a, lds, G, bid, tid, wid, lane); return; }
        constexpr int l = (PH > 0 ? PH - 1 : 0) / 9, k = (PH > 0 ? PH - 1 : 0) % 9;
#define Wl (Wb + (size_t)l * WL_STRIDE)
        if constexpr (PH == 0) { } else if constexpr (k == 0) { FRESH_LANE();
            pg8::Gemm g{XB, Wl + OFF_WIN, M, 2048, 1024, 1024}; pg8::StaticOrder S; S.init(M, 2048, G, bid);
            pg8::EpiBf16<0> E{Z, ZP, nullptr, 0, 0, 1.f};
            for (int rep = 0; rep < REP_GIN; ++rep)
            pg8::gemm_phase<pg8::EpiBf16<0>, pg8::StaticOrder, true, true>(lds, g, S, E, tid);
        } else if constexpr (k == 1) { FRESH_LANE();
            { const float* cqn = PT[10] + l * 64; const float* ckn = PT[11] + l * 64;
              for (int T = gw; T < M; T += 2 * NGW) { TokRegs R0, R1; const int T1 = (T + NGW < M) ? T + NGW : T;
                  token_load(R0, Z, tab, T, lane); token_load(R1, Z, tab, T1, lane);
                  token_finish(R0, Z, cqn, ckn, T, lane); if (T1 != T) token_finish(R1, Z, cqn, ckn, T1, lane); } }
            __syncthreads();
            for (int rep = 0; rep < REP_DIL; ++rep)
            for (int it = bid; it < 2304; it += G) dil_item(lds, it, Z, OB, LSE, biasT, tid, wid, lane);
        } else if constexpr (k == 2) { FRESH_LANE();
            { pg8::Gemm g{Z + ZC_AQ, Wl + OFF_WUQ, M, 512, 256, ZP}; pg8::StaticOrder S; S.init(M, 512, G, bid);
              EpiUq E{Z, tab}; pg8::gemm_phase<EpiUq, pg8::StaticOrder, true, true>(lds, g, S, E, tid); }
            { unsigned ones2_ = ~0u; asm volatile("" : "+s"(ones2_)); int lane2 = __builtin_amdgcn_mbcnt_hi(ones2_, __builtin_amdgcn_mbcnt_lo(ones2_, 0u));
              pg8::Gemm g{Z + ZC_AKV, Wl + OFF_WUKV, M, 512, 128, ZP}; pg8::StaticOrder S; S.init(M, 512, G, (bid + G / 2) % G);
              EpiUkv E{Z, VA}; pg8::gemm_phase<EpiUkv, pg8::StaticOrder, true, true>(lds, g, S, E, wid * 64 + lane2); }
        } else if constexpr (k == 3) { FRESH_LANE();
            for (int rep = 0; rep < REP_ATT; ++rep) {
            const int xme = (int)(xb_xcc_id() & 7u);
            for (int qi = 0; qi < 8; ++qi) {
                const int xq = (xme + qi) & 7;
                for (;;) {
                    if (tid == 0) *sh_item = (int)atomicAdd(ctl + 64 + (l * 2 + rep) * 8 + xq, 1u);
                    __syncthreads();
                    const int it = __builtin_amdgcn_readfirstlane(*sh_item);
                    __syncthreads();
                    if (it >= 384) break;
                    if (it >= 288) {
                        for (int tt = 0; tt < 8; ++tt) { const int T = 6144 * xq + 64 * (it - 288) + 8 * wid + tt;
                const int h = lane >> 4, d4 = (lane & 15) * 4;
                float ls[3], mx = -INFINITY;
#pragma unroll
                for (int p = 0; p < 3; ++p) { ls[p] = LSE[((size_t)p * M + T) * 4 + h]; mx = fmaxf(mx, ls[p]); }
                float den = 0.f; f32x4 o = (f32x4){0.f, 0.f, 0.f, 0.f};
#pragma unroll
                for (int p = 0; p < 3; ++p) { const float w = __builtin_amdgcn_exp2f(ls[p] - mx); den += w; const u32x2 v = *(const u32x2*)(OB + ((size_t)p * M + T) * 256 + h * 64 + d4);
                    o = o + (f32x4){bflo(v.x), bfhi(v.x), bflo(v.y), bfhi(v.y)} * w; }
                const float inv = 1.0f / den; u32x2 w; w.x = cvt_pk_bf16(o[0] * inv, o[1] * inv); w.y = cvt_pk_bf16(o[2] * inv, o[3] * inv);
                *(u32x2*)(XB + (size_t)T * 1024 + 256 + h * 64 + d4) = w;
                        }
                        continue;
                    }
                    int b, h, qb, nk; size_t r0; bool isA;
                    if (it < 32) { b = xq >> 2; h = xq & 3; qb = it; r0 = (size_t)b * 8192; nk = 8192; isA = true; }
                    else if (it < 96) { const int i2 = it - 32, pc = 2 * xq + (i2 >> 5); b = pc >> 3; h = pc & 7; qb = i2 & 31; r0 = (size_t)b * 8192; nk = 8192; isA = false; }
                    else if (it < 160) { const int i2 = it - 96, pa = 8 * xq + (i2 >> 3); b = pa >> 2; h = pa & 3; qb = i2 & 7; r0 = (size_t)NP + (size_t)b * 2048; nk = 2048; isA = true; }
                    else { const int i2 = it - 160, pc = 16 * xq + (i2 >> 3); b = pc >> 3; h = pc & 7; qb = i2 & 7; r0 = (size_t)NP + (size_t)b * 2048; nk = 2048; isA = false; }
                    const size_t rq = r0 + (size_t)qb * 256;
                    if (isA) dense_item<96>(lds, Z + rq * ZP + ZC_QA + h * 96, ZP, Z + r0 * ZP + ZC_KA + h * 96, Z + r0 * ZP + ZC_KRR, ZP, VA + r0 * 256 + h * 64, 256, XB + rq * 1024 + h * 64, 1024, nk, tid, wid, lane);
                    else dense_item<64>(lds, Z + rq * ZP + ZC_CQ + h * 64, ZP, Z + r0 * ZP + ZC_CK + (h >> 2) * 64, nullptr, ZP, Z + r0 * ZP + ZC_CV + (h >> 2) * 64, ZP, XB + rq * 1024 + 512 + h * 64, 1024, nk, tid, wid, lane);
                }
            } }
        } else if constexpr (k == 4) { FRESH_LANE();
            pg8::Gemm g{XB, Wl + OFF_WOUT, M, 1024, 1024, 1024}; pg8::StaticOrder S; S.init(M, 1024, G, bid);
            pg8::EpiBf16<0> E{MIX, 1024, nullptr, 0, 0, 1.f};
            pg8::gemm_phase<pg8::EpiBf16<0>, pg8::StaticOrder, true, true>(lds, g, S, E, tid);
        } else if constexpr (k == 5) { FRESH_LANE();
            phase_resnorm(MIX, PT[4] + l * 1024, X, XB, G, bid, wid, lane);
        } else if constexpr (k == 6) { FRESH_LANE();
            pg8::Gemm g{XB - 1024, Wl + OFF_WUP, 196 * 256, 5632, 1024, 1024}; pg8::StaticOrder S; S.init(196 * 256, 5632, G, bid);
            EpiUp E{GB, PT[16] + (size_t)l * 3 * 5632, PT[17] + (size_t)l * 5632};
            for (int rep = 0; rep < REP_GUP; ++rep)
            pg8::gemm_phase<EpiUp, pg8::StaticOrder, true, true, true>(lds, g, S, E, tid);
        } else if constexpr (k == 7) { FRESH_LANE();
            pg8::Gemm g{GB, Wl + OFF_WDN, M, 1024, 2816, 2816}; pg8::StaticOrder S; S.init(M, 1024, G, bid);
            pg8::EpiBf16<0> E{XB, 1024, nullptr, 0, 0, 1.f};
            for (int rep = 0; rep < REP_GDN; ++rep)
            pg8::gemm_phase<pg8::EpiBf16<0>, pg8::StaticOrder, true, true>(lds, g, S, E, tid);
        } else { FRESH_LANE();
            phase_resnorm<(PH != NPH - 1)>(XB, PT[14] + l * 1024, X, XB, G, bid, wid, lane);
        }
}
template <int PH>
__device__ __forceinline__ void run_all(const Args& a, LAS unsigned char* lds, cg::grid_group& grid, int wid0, int G0, int bid0) {
    if (a.ph_lo <= PH && PH < a.ph_hi) {
        if (PH > a.ph_lo) {
            unsigned ones_ = ~0u; asm volatile("" : "+s"(ones_)); const int lane_ = __builtin_amdgcn_mbcnt_hi(ones_, __builtin_amdgcn_mbcnt_lo(ones_, 0u));
            const bool leader = (wid0 == 0) && (lane_ == 0);
            unsigned* barw = (unsigned*)(a.ws + WS_CTL + 65536); volatile LAS unsigned* stw = (volatile LAS unsigned*)(lds + 143360 + 64);
            if constexpr (PH == 1) { grid.sync(); (void)xcd_barrier_post(barw, stw, leader); }
            else { XcdBarrier xb_; xb_.bar = barw; xb_.x = xb_xcc_id(); xb_.st = stw;
                for (int rep_ = 0; rep_ < REP_BAR; ++rep_) xcd_barrier(xb_, leader); }
        }
        run_phase<PH>(a, lds, wid0, G0, bid0);
    }
    if constexpr (PH + 1 < NPH) run_all<PH + 1>(a, lds, grid, wid0, G0, bid0);
}
__global__ void __launch_bounds__(512) mk_fwd(Args a) {
    extern __shared__ __attribute__((aligned(16))) unsigned char lds_raw[];
    LAS unsigned char* lds = (LAS unsigned char*)lds_raw;
    cg::grid_group grid = cg::this_grid();
    const int wid0 = __builtin_amdgcn_readfirstlane(threadIdx.x >> 6);
    const int G0 = gridDim.x, bid0 = blockIdx.x;
    if (threadIdx.x < 2) ((LAS unsigned*)(lds + 143360 + 64))[threadIdx.x] = 0u;
    __syncthreads();
    run_all<0>(a, lds, grid, wid0, G0, bid0);
}

extern "C" void kernel_launch(void* const* d_in, const int* in_sizes, int n_in, void* d_out, int out_size, void* d_ws, size_t ws_size, hipStream_t stream) {
    static int grid = 0;
    if (grid == 0) {
        if (n_in != 19 || out_size != M * D || ws_size < WS_END) { fprintf(stderr, "kernel_launch: unexpected shapes (n_in %d out %d ws %zu)\n", n_in, out_size, ws_size); grid = -1; return; }
        int dev = 0, cus = 0, per_cu = 0;
        hipGetDevice(&dev); hipDeviceGetAttribute(&cus, hipDeviceAttributeMultiprocessorCount, dev);
        if (hipFuncSetAttribute((const void*)mk_fwd, hipFuncAttributeMaxDynamicSharedMemorySize, LDS_BYTES) != hipSuccess) { fprintf(stderr, "kernel_launch: hipFuncSetAttribute failed\n"); grid = -1; return; }
        if (hipOccupancyMaxActiveBlocksPerMultiprocessor(&per_cu, (const void*)mk_fwd, 512, LDS_BYTES) != hipSuccess || per_cu < 1) { fprintf(stderr, "kernel_launch: occupancy query says %d\n", per_cu); per_cu = 1; }
        (void)hipGetLastError();
        grid = cus * per_cu;
    }
    if (grid < 0) return;
    Args a{};
    for (int i = 0; i < 19; ++i) a.in[i] = (const float*)d_in[i];
    a.out = (float*)d_out; a.ws = (unsigned char*)d_ws;
#ifdef MK_MULTI
    for (int ph = 0; ph < NPH; ++ph) { a.ph_lo = ph; a.ph_hi = ph + 1; hipLaunchKernelGGL(mk_fwd, dim3(grid), dim3(512), LDS_BYTES, stream, a); }
#else
    a.ph_lo = 0; a.ph_hi = NPH;
    void* args[] = {&a};
    hipError_t e = hipLaunchCooperativeKernel((const void*)mk_fwd, dim3(grid), dim3(512), args, LDS_BYTES, stream);
    if (e != hipSuccess) fprintf(stderr, "kernel_launch: cooperative launch failed: %s (grid %d)\n", hipGetErrorString(e), grid);
#endif
}
```
